# Optimizing an MI355X kernel written in HIP

```python
import math
import jax, jax.numpy as jnp
from jax import lax
import numpy as np

D_MODEL = 2048
BATCH = 4
SEQ = 4096
DEPTH = 2

CHUNK = 64
N_MIXERS = 2
N_A = (DEPTH + 1) // 2
N_B = DEPTH // 2
S5_GROUP = 16
S5_GROUPS = D_MODEL // S5_GROUP
S5_STATE = 64
S5_DT_MIN = 0.001
S5_DT_MAX = 0.1
SB_HEAD_DIM = 128
SB_HEADS = D_MODEL // SB_HEAD_DIM
Q_BLOCK = 128
D_FF = 5632
FFN_RES = 0.5
EPS = 1e-6

kernel_name = "hybrid_s5_stickbreaking_macaron"


def rmsnorm(x, g):
    xf = x.astype(jnp.float32)
    y = xf * lax.rsqrt(jnp.mean(xf * xf, axis=-1, keepdims=True) + EPS)
    return (y * g.astype(jnp.float32)).astype(x.dtype)


def swiglu(h, w_gate, w_up, w_down):
    return (jax.nn.silu(h @ w_gate) * (h @ w_up)) @ w_down


def _complex_scan_combine(left, right):
    a1r, a1i, b1r, b1i = left
    a2r, a2i, b2r, b2i = right
    return (a2r * a1r - a2i * a1i,
            a2r * a1i + a2i * a1r,
            a2r * b1r - a2i * b1i + b2r,
            a2r * b1i + a2i * b1r + b2i)


def s5_mixer(h, w_in, lam_re, lam_im, log_dt, b_re, b_im, c_re, c_im, d_skip, w_glu, b_glu, w_out):
    f32 = jnp.float32
    bsz, seq, _ = h.shape
    n_chunks = seq // CHUNK
    u = (h @ w_in).astype(f32)
    dt = jnp.exp(log_dt.astype(f32))[:, None]
    lr = jnp.minimum(lam_re.astype(f32), -1e-4)
    li = lam_im.astype(f32)
    mag = jnp.exp(lr * dt)
    ab_re = mag * jnp.cos(li * dt)
    ab_im = mag * jnp.sin(li * dt)
    den = lr * lr + li * li
    n_re = ab_re - 1.0
    f_re = (n_re * lr + ab_im * li) / den
    f_im = (ab_im * lr - n_re * li) / den
    br = b_re.astype(f32)
    bi = b_im.astype(f32)
    bb_re = f_re[..., None] * br - f_im[..., None] * bi
    bb_im = f_re[..., None] * bi + f_im[..., None] * br
    cr = c_re.astype(f32)
    ci = c_im.astype(f32)

    uc = u.reshape(bsz, n_chunks, CHUNK, S5_GROUPS, S5_GROUP).transpose(1, 0, 2, 3, 4)
    a_re = jnp.broadcast_to(ab_re, (bsz, CHUNK, S5_GROUPS, S5_STATE))
    a_im = jnp.broadcast_to(ab_im, (bsz, CHUNK, S5_GROUPS, S5_STATE))

    def chunk_step(carry, u_chunk):
        s_re0, s_im0 = carry
        bu_re = jnp.einsum('bcgh,gph->bcgp', u_chunk, bb_re)
        bu_im = jnp.einsum('bcgh,gph->bcgp', u_chunk, bb_im)
        bu_re = bu_re.at[:, 0].add(ab_re * s_re0 - ab_im * s_im0)
        bu_im = bu_im.at[:, 0].add(ab_re * s_im0 + ab_im * s_re0)
        _, _, s_re, s_im = lax.associative_scan(_complex_scan_combine, (a_re, a_im, bu_re, bu_im), axis=1)
        y = jnp.einsum('bcgp,ghp->bcgh', s_re, cr) - jnp.einsum('bcgp,ghp->bcgh', s_im, ci)
        return (s_re[:, -1], s_im[:, -1]), y

    s0 = jnp.zeros((bsz, S5_GROUPS, S5_STATE), f32)
    _, yc = lax.scan(chunk_step, (s0, s0), uc)
    y = yc.transpose(1, 0, 2, 3, 4).reshape(bsz, seq, S5_GROUPS * S5_GROUP)
    y = y + d_skip.astype(f32) * u
    y = jax.nn.gelu(y).astype(h.dtype)
    y = y * jax.nn.sigmoid(y @ w_glu + b_glu)
    return y @ w_out


def stick_breaking_mixer(h, w_qkv, g_q, g_k, w_o):
    f32 = jnp.float32
    bsz, seq, _ = h.shape
    qkv = (h @ w_qkv).reshape(bsz, seq, 3, SB_HEADS, SB_HEAD_DIM)
    q = rmsnorm(qkv[:, :, 0], g_q).transpose(0, 2, 1, 3)
    k = rmsnorm(qkv[:, :, 1], g_k).transpose(0, 2, 1, 3)
    v = qkv[:, :, 2].transpose(0, 2, 1, 3)
    scale = 1.0 / math.sqrt(SB_HEAD_DIM)
    outs = []
    for blk in range(seq // Q_BLOCK):
        q0 = blk * Q_BLOCK
        kv_len = q0 + Q_BLOCK
        qb = q[:, :, q0:kv_len].astype(f32)
        kb = k[:, :, :kv_len].astype(f32)
        vb = v[:, :, :kv_len]
        z = jnp.einsum('bhqd,bhkd->bhqk', qb, kb) * scale
        t_idx = q0 + jnp.arange(Q_BLOCK)[:, None]
        s_idx = jnp.arange(kv_len)[None, :]
        past = s_idx < t_idx
        log_beta = jax.nn.log_sigmoid(z)
        log_keep = jnp.where(past, jax.nn.log_sigmoid(-z), 0.0)
        log_stick = lax.cumsum(log_keep, axis=3, reverse=True) - log_keep
        w = jnp.where(past, jnp.exp(log_beta + log_stick), 0.0)
        outs.append(jnp.einsum('bhqk,bhkd->bhqd', w.astype(v.dtype), vb))
    o = jnp.concatenate(outs, axis=2)
    o = o.transpose(0, 2, 1, 3).reshape(bsz, seq, SB_HEADS * SB_HEAD_DIM)
    return o @ w_o


def setup_inputs(seed: int = 0) -> dict:
    key = jax.random.key(seed)
    ks = iter(jax.random.split(key, 40))
    f32 = jnp.float32
    D, F = D_MODEL, D_FF
    G, H, P = S5_GROUPS, S5_GROUP, S5_STATE

    def nrm(shape, scale):
        return jax.random.normal(next(ks), shape, f32) * scale

    def gain(shape):
        return jnp.ones(shape, f32) + 0.02 * jax.random.normal(next(ks), shape, f32)

    x = jax.random.normal(next(ks), (BATCH, SEQ, D), f32)
    norm_ffn1 = gain((DEPTH, D))
    ffn1_w_gate = nrm((DEPTH, D, F), D ** -0.5)
    ffn1_w_up = nrm((DEPTH, D, F), D ** -0.5)
    ffn1_w_down = nrm((DEPTH, F, D), F ** -0.5)
    norm_mix = gain((DEPTH, D))
    s5_w_in = nrm((N_A, D, G * H), D ** -0.5)
    s5_lam_re = -0.5 + 0.01 * jax.random.normal(next(ks), (N_A, G, P), f32)
    s5_lam_im = math.pi * jnp.arange(P, dtype=f32)[None, None, :] + 0.01 * jax.random.normal(next(ks), (N_A, G, P), f32)
    s5_log_dt = jax.random.uniform(next(ks), (N_A, G), f32, math.log(S5_DT_MIN), math.log(S5_DT_MAX))
    s5_b_re = nrm((N_A, G, P, H), (2 * H) ** -0.5)
    s5_b_im = nrm((N_A, G, P, H), (2 * H) ** -0.5)
    s5_c_re = nrm((N_A, G, H, P), P ** -0.5)
    s5_c_im = nrm((N_A, G, H, P), P ** -0.5)
    s5_d = nrm((N_A, G * H), 1.0)
    s5_w_glu = nrm((N_A, G * H, G * H), (G * H) ** -0.5)
    s5_b_glu = nrm((N_A, G * H), 0.01)
    s5_w_out = nrm((N_A, G * H, D), (G * H) ** -0.5)
    sb_w_qkv = nrm((N_B, D, 3 * SB_HEADS * SB_HEAD_DIM), D ** -0.5)
    sb_g_q = gain((N_B, SB_HEAD_DIM))
    sb_g_k = gain((N_B, SB_HEAD_DIM))
    sb_w_o = nrm((N_B, SB_HEADS * SB_HEAD_DIM, D), (SB_HEADS * SB_HEAD_DIM) ** -0.5)
    norm_ffn2 = gain((DEPTH, D))
    ffn2_w_gate = nrm((DEPTH, D, F), D ** -0.5)
    ffn2_w_up = nrm((DEPTH, D, F), D ** -0.5)
    ffn2_w_down = nrm((DEPTH, F, D), F ** -0.5)
    return {
        "x": x,
        "norm_ffn1": norm_ffn1, "ffn1_w_gate": ffn1_w_gate, "ffn1_w_up": ffn1_w_up, "ffn1_w_down": ffn1_w_down,
        "norm_mix": norm_mix,
        "s5_w_in": s5_w_in, "s5_lam_re": s5_lam_re, "s5_lam_im": s5_lam_im, "s5_log_dt": s5_log_dt,
        "s5_b_re": s5_b_re, "s5_b_im": s5_b_im, "s5_c_re": s5_c_re, "s5_c_im": s5_c_im, "s5_d": s5_d,
        "s5_w_glu": s5_w_glu, "s5_b_glu": s5_b_glu, "s5_w_out": s5_w_out,
        "sb_w_qkv": sb_w_qkv, "sb_g_q": sb_g_q, "sb_g_k": sb_g_k, "sb_w_o": sb_w_o,
        "norm_ffn2": norm_ffn2, "ffn2_w_gate": ffn2_w_gate, "ffn2_w_up": ffn2_w_up, "ffn2_w_down": ffn2_w_down,
    }


def reference(x, norm_ffn1, ffn1_w_gate, ffn1_w_up, ffn1_w_down, norm_mix,
              s5_w_in, s5_lam_re, s5_lam_im, s5_log_dt, s5_b_re, s5_b_im, s5_c_re, s5_c_im, s5_d,
              s5_w_glu, s5_b_glu, s5_w_out,
              sb_w_qkv, sb_g_q, sb_g_k, sb_w_o,
              norm_ffn2, ffn2_w_gate, ffn2_w_up, ffn2_w_down):
    for i in range(DEPTH):
        h = rmsnorm(x, norm_ffn1[i])
        x = x + FFN_RES * swiglu(h, ffn1_w_gate[i], ffn1_w_up[i], ffn1_w_down[i])
        h = rmsnorm(x, norm_mix[i])
        j = i // N_MIXERS
        if i % N_MIXERS == 0:
            x = x + s5_mixer(h, s5_w_in[j], s5_lam_re[j], s5_lam_im[j], s5_log_dt[j],
                             s5_b_re[j], s5_b_im[j], s5_c_re[j], s5_c_im[j], s5_d[j],
                             s5_w_glu[j], s5_b_glu[j], s5_w_out[j])
        else:
            x = x + stick_breaking_mixer(h, sb_w_qkv[j], sb_g_q[j], sb_g_k[j], sb_w_o[j])
        h = rmsnorm(x, norm_ffn2[i])
        x = x + FFN_RES * swiglu(h, ffn2_w_gate[i], ffn2_w_up[i], ffn2_w_down[i])
    return x
```

```cpp
#include <hip/hip_runtime.h>
#include <hip/hip_cooperative_groups.h>
#include <cstdio>
#include <cstdint>
namespace cg = cooperative_groups;
#ifndef MK_MULTI
#define MK_MULTI 0
#endif
namespace pg8 {
#define PG8_LAS __attribute__((address_space(3)))
typedef unsigned short bf16_t;
typedef short bf16x8 __attribute__((ext_vector_type(8)));
typedef float f32x4 __attribute__((ext_vector_type(4)));
typedef unsigned u32x4 __attribute__((ext_vector_type(4)));
constexpr int BM = 256, BK = 64, HALF = 128, HTB = HALF * BK * 2  , STAGE_BYTES = 8 * HTB, NXCD = 8, WGM = 8;

__host__ __device__ __forceinline__ int lds_byte(int r, int c) { const int st = (r >> 4) * 2 + (c >> 5), rr = r & 15, cc = c & 31, ob = rr * 64 + cc * 2; return st * 1024 + (ob ^ (((ob >> 9) & 1) << 5)); }
__host__ __device__ __forceinline__ void stage_rc(int b, int& R, int& C) { const int st = b / 1024, sb = b % 1024, swz = sb ^ (((sb >> 9) & 1) << 5); R = (st >> 1) * 16 + swz / 64; C = (st & 1) * 32 + (swz % 64) / 2; }
__host__ __device__ __forceinline__ int perm32(int rho) { const int n = rho >> 4, i = rho & 15; return 8 * (i >> 2) + 4 * n + (i & 3); }

struct Unit { int pm, pn; };
struct Gemm { const bf16_t* A; const bf16_t* Bt; int M, N, K; };

struct StaticOrder {
    int nM, nN, nwg, G, c, wgm;
    __host__ __device__ void init(int M, int N, int G_, int c_, int wgm_ = WGM) { nM = M / BM; nN = N / BM; nwg = nM * nN; G = G_; c = c_; wgm = wgm_; }
    __host__ __device__ bool next(int i, Unit& u) const {
        const long L = (long)i * G + c; if (L >= nwg) return false;
        int wgid = (int)L; { const int q = nwg / NXCD, r = nwg % NXCD, xcd = wgid % NXCD, off = wgid / NXCD; wgid = (xcd < r ? xcd * (q + 1) : r * (q + 1) + (xcd - r) * q) + off; }
        const int nig = wgm * nN, gid = wgid / nig, fm = gid * wgm, gsz = (nM - fm) < wgm ? (nM - fm) : wgm;
        u.pm = fm + ((wgid % nig) % gsz); u.pn = (wgid % nig) / gsz; return true;
    }
    __device__ __forceinline__ void a_ready(const Unit&) const {}
    __device__ __forceinline__ void done(const Unit&) const {}
};
__device__ __forceinline__ unsigned cvt_pk_bf16(float lo, float hi) { unsigned r; asm volatile("v_cvt_pk_bf16_f32 %0, %1, %2" : "=v"(r) : "v"(lo), "v"(hi)); return r; }
typedef float f32x2 __attribute__((ext_vector_type(2)));
typedef __bf16 bf16x2_t __attribute__((ext_vector_type(2)));
__device__ __forceinline__ unsigned pk_bf16(float lo, float hi) { f32x2 v = {lo, hi}; bf16x2_t b = __builtin_convertvector(v, bf16x2_t); return __builtin_bit_cast(unsigned, b); }
__device__ __forceinline__ float bf_lo(unsigned w) { return __builtin_bit_cast(float, w << 16); }
__device__ __forceinline__ float bf_hi(unsigned w) { return __builtin_bit_cast(float, w & 0xffff0000u); }
__device__ __forceinline__ float sigmoid_fast(float v) { return __builtin_amdgcn_rcpf(1.0f + __builtin_amdgcn_exp2f(-1.44269504089f * v)); }
__device__ __forceinline__ float rstd_val(float ss) { return __builtin_amdgcn_rsqf(ss * (1.0f / 2048.0f) + 1e-6f); }
constexpr int SSLDS_OFF = 131072 + 1024;
struct EpiSwiGLU {
    static constexpr bool PERM = true, AFTER_DRAIN = false, SSPRE = true;
    bf16_t* O; int ldc; const float* SS; PG8_LAS unsigned char* LDSB;
    __device__ __forceinline__ void operator()(const f32x4 (&acc)[2][2][4][2], const Unit& u, int wr, int wc, int fr, int fq) const {
        const int row0 = u.pm * BM + wr * 64 + fr, col0 = u.pn * HALF + wc * 32 + 8 * fq;
        const PG8_LAS float* ssl = (const PG8_LAS float*)(LDSB + SSLDS_OFF);
        float rsv[2][4];
#pragma unroll
        for (int ai = 0; ai < 2; ++ai)
#pragma unroll
            for (int m = 0; m < 4; ++m) rsv[ai][m] = (float)((const PG8_LAS unsigned*)ssl)[ai * HALF + wr * 64 + m * 16 + fr] * (1.0f / 4096.0f);
#pragma unroll
        for (int ai = 0; ai < 2; ++ai)
#pragma unroll
            for (int m = 0; m < 4; ++m) { bf16_t* rowp = O + (size_t)(row0 + ai * HALF + m * 16) * ldc + col0;
                const float rs = rstd_val(rsv[ai][m]);
                float v[8];
#pragma unroll
                for (int n = 0; n < 2; ++n) {
                    const f32x4 g4 = acc[ai][0][m][n] * rs, u4 = acc[ai][1][m][n] * rs, a4 = g4 * (-1.44269504089f), p4 = g4 * u4;
                    f32x4 e4; e4[0] = __builtin_amdgcn_exp2f(a4[0]); e4[1] = __builtin_amdgcn_exp2f(a4[1]); e4[2] = __builtin_amdgcn_exp2f(a4[2]); e4[3] = __builtin_amdgcn_exp2f(a4[3]);
                    const f32x4 d4 = e4 + 1.0f;
                    f32x4 r4; r4[0] = __builtin_amdgcn_rcpf(d4[0]); r4[1] = __builtin_amdgcn_rcpf(d4[1]); r4[2] = __builtin_amdgcn_rcpf(d4[2]); r4[3] = __builtin_amdgcn_rcpf(d4[3]);
                    const f32x4 o4 = p4 * r4;
                    v[4 * n] = o4[0]; v[4 * n + 1] = o4[1]; v[4 * n + 2] = o4[2]; v[4 * n + 3] = o4[3]; }
                u32x4 w; w.x = pk_bf16(v[0], v[1]); w.y = pk_bf16(v[2], v[3]); w.z = pk_bf16(v[4], v[5]); w.w = pk_bf16(v[6], v[7]);
                *(u32x4*)rowp = w; }
    }
};
typedef unsigned u32x2v __attribute__((ext_vector_type(2)));
struct EpiRes {
    static constexpr bool PERM = true, AFTER_DRAIN = false, SSPRE = false;
    float* OUT; int ldc; int half; bf16_t* XB; float* SSo;
    __device__ __forceinline__ void operator()(const f32x4 (&acc)[2][2][4][2], const Unit& u, int wr, int wc, int fr, int fq) const {
        const int row0 = u.pm * BM + wr * 64 + fr, col0 = u.pn * BM + wc * 32 + 8 * fq;
        const float alpha = half ? 0.5f : 1.0f;
#pragma unroll
        for (int ai = 0; ai < 2; ++ai) {
            u32x4 rv[4][2];
#pragma unroll
            for (int m = 0; m < 4; ++m)
#pragma unroll
                for (int bj = 0; bj < 2; ++bj) rv[m][bj] = *(const u32x4*)(XB + (size_t)(row0 + ai * HALF + m * 16) * ldc + col0 + bj * HALF);
#pragma unroll
            for (int m = 0; m < 4; ++m) { const size_t off = (size_t)(row0 + ai * HALF + m * 16) * ldc + col0;
                float ssum = 0.f;
#pragma unroll
                for (int bj = 0; bj < 2; ++bj) { const u32x4 r = rv[m][bj];
                    const f32x4 v0 = (f32x4){bf_lo(r.x), bf_hi(r.x), bf_lo(r.y), bf_hi(r.y)} + acc[ai][bj][m][0] * alpha, v1 = (f32x4){bf_lo(r.z), bf_hi(r.z), bf_lo(r.w), bf_hi(r.w)} + acc[ai][bj][m][1] * alpha;
                    if (OUT) { *(f32x4*)(OUT + off + bj * HALF) = v0; *(f32x4*)(OUT + off + bj * HALF + 4) = v1; }
                    else { u32x4 w; w.x = pk_bf16(v0[0], v0[1]); w.y = pk_bf16(v0[2], v0[3]); w.z = pk_bf16(v1[0], v1[1]); w.w = pk_bf16(v1[2], v1[3]); *(u32x4*)(XB + off + bj * HALF) = w;
                        ssum += ((v0[0] * v0[0] + v0[1] * v0[1]) + (v0[2] * v0[2] + v0[3] * v0[3])) + ((v1[0] * v1[0] + v1[1] * v1[1]) + (v1[2] * v1[2] + v1[3] * v1[3])); } }
                if (!OUT) { ssum += __shfl_xor(ssum, 16); ssum += __shfl_xor(ssum, 32); if (fq == 0) atomicAdd((unsigned*)SSo + row0 + ai * HALF + m * 16, (unsigned)(ssum * 4096.0f + 0.5f)); } }
            asm volatile("" ::: "memory"); }
    }
};
struct EpiF32 {
    static constexpr bool PERM = false, AFTER_DRAIN = false, SSPRE = true;
    float* C; int ldc; const float* SS; PG8_LAS unsigned char* LDSB;
    __device__ __forceinline__ void operator()(const f32x4 (&acc)[2][2][4][2], const Unit& u, int wr, int wc, int fr, int fq) const {
        const int row0 = u.pm * BM + wr * 64 + fr, col0 = u.pn * BM + wc * 32 + 4 * fq;
        const PG8_LAS float* ssl = (const PG8_LAS float*)(LDSB + SSLDS_OFF);
        float rsv[2][4];
#pragma unroll
        for (int ai = 0; ai < 2; ++ai)
#pragma unroll
            for (int m = 0; m < 4; ++m) rsv[ai][m] = (float)((const PG8_LAS unsigned*)ssl)[ai * HALF + wr * 64 + m * 16 + fr] * (1.0f / 4096.0f);
#pragma unroll
        for (int ai = 0; ai < 2; ++ai)
#pragma unroll
            for (int m = 0; m < 4; ++m) { float* rowp = C + (size_t)(row0 + ai * HALF + m * 16) * ldc + col0; const float rs = rstd_val(rsv[ai][m]);
#pragma unroll
                for (int bj = 0; bj < 2; ++bj)
#pragma unroll
                    for (int n = 0; n < 2; ++n) *(f32x4*)(rowp + bj * HALF + n * 16) = acc[ai][bj][m][n] * rs; }
    }
};
struct EpiBf16 {
    static constexpr bool PERM = true, AFTER_DRAIN = false, SSPRE = true;
    bf16_t* O; int ldc; const float* SS; PG8_LAS unsigned char* LDSB;
    __device__ __forceinline__ void operator()(const f32x4 (&acc)[2][2][4][2], const Unit& u, int wr, int wc, int fr, int fq) const {
        const int row0 = u.pm * BM + wr * 64 + fr, col0 = u.pn * BM + wc * 32 + 8 * fq;
        const PG8_LAS float* ssl = (const PG8_LAS float*)(LDSB + SSLDS_OFF);
        float rsv[2][4];
#pragma unroll
        for (int ai = 0; ai < 2; ++ai)
#pragma unroll
            for (int m = 0; m < 4; ++m) rsv[ai][m] = (float)((const PG8_LAS unsigned*)ssl)[ai * HALF + wr * 64 + m * 16 + fr] * (1.0f / 4096.0f);
#pragma unroll
        for (int ai = 0; ai < 2; ++ai)
#pragma unroll
            for (int m = 0; m < 4; ++m) { bf16_t* rowp = O + (size_t)(row0 + ai * HALF + m * 16) * ldc + col0; const float rs = rstd_val(rsv[ai][m]);
#pragma unroll
                for (int bj = 0; bj < 2; ++bj) { const f32x4 v0 = acc[ai][bj][m][0] * rs, v1 = acc[ai][bj][m][1] * rs;
                    u32x4 w; w.x = pk_bf16(v0[0], v0[1]); w.y = pk_bf16(v0[2], v0[3]); w.z = pk_bf16(v1[0], v1[1]); w.w = pk_bf16(v1[2], v1[3]);
                    *(u32x4*)(rowp + bj * HALF) = w; } }
    }
};
constexpr int PART_OFF = 131072 + 2048;
struct EpiQKV {
    static constexpr bool PERM = true, AFTER_DRAIN = false, SSPRE = true;
    bf16_t* O; int ldc; const float* SS; PG8_LAS unsigned char* LDSB; const float* gq; const float* gk; bf16_t* Vt;
    __device__ __forceinline__ void operator()(const f32x4 (&acc)[2][2][4][2], const Unit& u, int wr, int wc, int fr, int fq) const {
        const int row0 = u.pm * BM + wr * 64 + fr, colt = u.pn * BM, which = colt >> 11;
        const PG8_LAS float* ssl = (const PG8_LAS float*)(LDSB + SSLDS_OFF);
        float rsv[2][4];
#pragma unroll
        for (int ai = 0; ai < 2; ++ai)
#pragma unroll
            for (int m = 0; m < 4; ++m) rsv[ai][m] = rstd_val((float)((const PG8_LAS unsigned*)ssl)[ai * HALF + wr * 64 + m * 16 + fr] * (1.0f / 4096.0f));
        if (which < 2) {
            PG8_LAS float* part = (PG8_LAS float*)(LDSB + PART_OFF);
#pragma unroll
            for (int ai = 0; ai < 2; ++ai)
#pragma unroll
                for (int m = 0; m < 4; ++m)
#pragma unroll
                    for (int bj = 0; bj < 2; ++bj) { const float rs = rsv[ai][m]; const f32x4 v0 = acc[ai][bj][m][0] * rs, v1 = acc[ai][bj][m][1] * rs;
                        float s = ((v0[0] * v0[0] + v0[1] * v0[1]) + (v0[2] * v0[2] + v0[3] * v0[3])) + ((v1[0] * v1[0] + v1[1] * v1[1]) + (v1[2] * v1[2] + v1[3] * v1[3]));
                        s += __shfl_xor(s, 16); s += __shfl_xor(s, 32);
                        if (fq == 0) part[((ai * HALF + wr * 64 + m * 16 + fr) * 2 + bj) * 4 + wc] = s; }
            asm volatile("s_waitcnt lgkmcnt(0)" ::: "memory"); __builtin_amdgcn_s_barrier(); asm volatile("" ::: "memory");
            const float* gn = (which ? gk : gq) + wc * 32 + 8 * fq; const f32x4 ga = *(const f32x4*)gn, gb = *(const f32x4*)(gn + 4);
            const float qs = which ? 1.0f : 0.08838834764831845f * 1.4426950408889634f;
#pragma unroll
            for (int ai = 0; ai < 2; ++ai)
#pragma unroll
                for (int m = 0; m < 4; ++m) { bf16_t* rowp = O + (size_t)(row0 + ai * HALF + m * 16) * ldc + colt + wc * 32 + 8 * fq;
#pragma unroll
                    for (int bj = 0; bj < 2; ++bj) { const f32x4 p4 = *(const PG8_LAS f32x4*)(part + ((ai * HALF + wr * 64 + m * 16 + fr) * 2 + bj) * 4);
                        const float hr = rsv[ai][m] * qs * __builtin_amdgcn_rsqf(((p4[0] + p4[1]) + (p4[2] + p4[3])) * (1.0f / 128.0f) + 1e-6f);
                        const f32x4 v0 = acc[ai][bj][m][0] * hr * ga, v1 = acc[ai][bj][m][1] * hr * gb;
                        u32x4 w; w.x = pk_bf16(v0[0], v0[1]); w.y = pk_bf16(v0[2], v0[3]); w.z = pk_bf16(v1[0], v1[1]); w.w = pk_bf16(v1[2], v1[3]);
                        *(u32x4*)(rowp + bj * HALF) = w; } }
        } else {
#pragma unroll
            for (int ai = 0; ai < 2; ++ai)
#pragma unroll
                for (int m = 0; m < 4; ++m) { const int row = row0 + ai * HALF + m * 16, b = row >> 12, tok = row & 4095; const float rs = rsv[ai][m];
#pragma unroll
                    for (int bj = 0; bj < 2; ++bj) { const int head = ((colt - 4096) >> 7) + bj;
                        bf16_t* vp = Vt + ((size_t)((b * 16 + head) * 128 + wc * 32 + 8 * fq)) * 4096 + tok;
#pragma unroll
                        for (int n = 0; n < 2; ++n)
#pragma unroll
                            for (int j = 0; j < 4; ++j) vp[(size_t)(4 * n + j) * 4096] = (bf16_t)(pk_bf16(acc[ai][bj][m][n][j] * rs, 0.f) & 0xffffu); } }
        }
    }
};
struct EpiGlu {
    static constexpr bool PERM = true, AFTER_DRAIN = false, SSPRE = false;
    const bf16_t* Y; bf16_t* O; int ldc; const float* bias;
    __device__ __forceinline__ void operator()(const f32x4 (&acc)[2][2][4][2], const Unit& u, int wr, int wc, int fr, int fq) const {
        const int row0 = u.pm * BM + wr * 64 + fr, col0 = u.pn * BM + wc * 32 + 8 * fq;
        f32x4 bv[2][2];
#pragma unroll
        for (int bj = 0; bj < 2; ++bj)
#pragma unroll
            for (int n = 0; n < 2; ++n) bv[bj][n] = *(const f32x4*)(bias + col0 + bj * HALF + 4 * n);
#pragma unroll
        for (int ai = 0; ai < 2; ++ai) {
            u32x4 yy[4][2];
#pragma unroll
            for (int m = 0; m < 4; ++m)
#pragma unroll
                for (int bj = 0; bj < 2; ++bj) yy[m][bj] = *(const u32x4*)(Y + (size_t)(row0 + ai * HALF + m * 16) * ldc + col0 + bj * HALF);
#pragma unroll
            for (int m = 0; m < 4; ++m) { const size_t off = (size_t)(row0 + ai * HALF + m * 16) * ldc + col0;
#pragma unroll
                for (int bj = 0; bj < 2; ++bj) { const u32x4 yv = yy[m][bj];
                    const f32x4 g0 = acc[ai][bj][m][0] + bv[bj][0], g1 = acc[ai][bj][m][1] + bv[bj][1];
                    u32x4 w;
                    w.x = pk_bf16(bf_lo(yv.x) * sigmoid_fast(g0[0]), bf_hi(yv.x) * sigmoid_fast(g0[1]));
                    w.y = pk_bf16(bf_lo(yv.y) * sigmoid_fast(g0[2]), bf_hi(yv.y) * sigmoid_fast(g0[3]));
                    w.z = pk_bf16(bf_lo(yv.z) * sigmoid_fast(g1[0]), bf_hi(yv.z) * sigmoid_fast(g1[1]));
                    w.w = pk_bf16(bf_lo(yv.w) * sigmoid_fast(g1[2]), bf_hi(yv.w) * sigmoid_fast(g1[3]));
                    *(u32x4*)(O + off + bj * HALF) = w; } }
            asm volatile("" ::: "memory"); }
    }
};
template <class Epi, class Sched, bool ALIGN_EPI = false, bool SP2 = false>
__device__ __forceinline__ void gemm_phase(PG8_LAS unsigned char* lds, const Gemm g, const Sched& S, const Epi& E, const int tid) {
    const int wid = __builtin_amdgcn_readfirstlane(tid >> 6), lane = tid & 63, wr = wid >> 2, wc = wid & 3, fr = lane & 15, fq = lane >> 4;
    const int K = g.K, nt = K / BK;
    unsigned voffA[2], voffB[2];
#pragma unroll
    for (int i = 0; i < 2; ++i) { int R, C; stage_rc(tid * 16 + i * 8192, R, C); const int Rb = Epi::PERM ? ((R & ~31) + perm32(R & 31)) : R;
        voffA[i] = (unsigned)(R * K + C) * 2u; voffB[i] = (unsigned)(Rb * K + C) * 2u; }
    const size_t kstep = (size_t)(BK * 2);
    const size_t hstep = (size_t)HALF * K * 2;
    const size_t tstep = 2 * hstep;
    const unsigned ldsw = (unsigned)wid * 1024u;
    const int aoff = lds_byte(wr * 64 + fr, fq * 8), boff = lds_byte(wc * 32 + fr, fq * 8);
#define PG8_SA(b, h) (((b) * 2 + (h)) * HTB)
#define PG8_SB(b, h) ((4 + (b) * 2 + (h)) * HTB)
#define PG8_STAGE(bufoff, gbase, voff) do { _Pragma("unroll") for (int _i = 0; _i < 2; ++_i) \
        __builtin_amdgcn_global_load_lds((const unsigned*)((const char*)(gbase) + (voff)[_i]), (PG8_LAS unsigned*)(lds + (bufoff) + ldsw + _i * 8192), 16, 0, 0); } while (0)
#define PG8_LDA(dst, b, h) do { _Pragma("unroll") for (int m = 0; m < 4; ++m) _Pragma("unroll") for (int k = 0; k < 2; ++k) dst[m][k] = *(const PG8_LAS bf16x8*)(lds + PG8_SA(b, h) + aoff + m * 2048 + k * 1024); } while (0)
#define PG8_LDB(dst, b, h) do { _Pragma("unroll") for (int n = 0; n < 2; ++n) _Pragma("unroll") for (int k = 0; k < 2; ++k) dst[n][k] = *(const PG8_LAS bf16x8*)(lds + PG8_SB(b, h) + boff + n * 2048 + k * 1024); } while (0)
#define PG8_MMA(ai, bj, At, Bt) do { __builtin_amdgcn_s_setprio(1); _Pragma("unroll") for (int m = 0; m < 4; ++m) _Pragma("unroll") for (int n = 0; n < 2; ++n) _Pragma("unroll") for (int k = 0; k < 2; ++k) \
        acc[ai][bj][m][n] = __builtin_amdgcn_mfma_f32_16x16x32_bf16(Bt[n][k], At[m][k], acc[ai][bj][m][n], 0, 0, 0); __builtin_amdgcn_s_setprio(0); } while (0)
#define PG8_WAIT_V(n) asm volatile("s_waitcnt vmcnt(" #n ")" ::: "memory")
#define PG8_WAIT_L(n) asm volatile("s_waitcnt lgkmcnt(" #n ")" ::: "memory")
#define PG8_BAR __builtin_amdgcn_s_barrier()
#define PG8_SCHED __builtin_amdgcn_sched_barrier(0)
    Unit cur, nxt; int ui = 0;
    if (!S.next(0, cur)) return;
    f32x4 acc[2][2][4][2];
#pragma unroll
    for (int a = 0; a < 2; ++a)
#pragma unroll
        for (int b = 0; b < 2; ++b)
#pragma unroll
            for (int m = 0; m < 4; ++m)
#pragma unroll
                for (int n = 0; n < 2; ++n) acc[a][b][m][n] = (f32x4){0.f, 0.f, 0.f, 0.f};
    bf16x8 At[4][2], B0[2][2], B1[2][2];
    const char* cA = (const char*)g.A + (size_t)cur.pm * tstep; const char* cB = (const char*)g.Bt + (size_t)cur.pn * tstep;
    S.a_ready(cur);
    if constexpr (SP2) {
        PG8_STAGE(PG8_SB(0, 0), cB, voffB); PG8_STAGE(PG8_SB(0, 1), cB + hstep, voffB); PG8_STAGE(PG8_SA(0, 0), cA, voffA); PG8_STAGE(PG8_SA(0, 1), cA + hstep, voffA);
        if (wr == 1) PG8_BAR;
        PG8_WAIT_V(2); PG8_BAR;
        PG8_STAGE(PG8_SB(1, 0), cB + kstep, voffB); PG8_STAGE(PG8_SA(1, 0), cA + kstep, voffA); PG8_STAGE(PG8_SB(1, 1), cB + hstep + kstep, voffB);
        PG8_WAIT_V(6); PG8_BAR;
    } else {
        PG8_STAGE(PG8_SB(0, 0), cB, voffB); PG8_STAGE(PG8_SA(0, 0), cA, voffA); PG8_STAGE(PG8_SB(0, 1), cB + hstep, voffB); PG8_STAGE(PG8_SA(0, 1), cA + hstep, voffA);
        if (wr == 1) PG8_BAR;
        PG8_WAIT_V(4); PG8_BAR;
        PG8_STAGE(PG8_SB(1, 0), cB + kstep, voffB); PG8_STAGE(PG8_SA(1, 0), cA + kstep, voffA); PG8_STAGE(PG8_SB(1, 1), cB + hstep + kstep, voffB);
        PG8_WAIT_V(6); PG8_BAR;
    }
    for (;;) {
        const bool has_next = S.next(ui + 1, nxt);
        const char* nA = has_next ? (const char*)g.A + (size_t)nxt.pm * tstep : cA; const char* nB = has_next ? (const char*)g.Bt + (size_t)nxt.pn * tstep : cB;
        for (int t = 0; t < nt; t += 2) {
            const bool last = (t == nt - 2);
            const char* a1 = cA + (size_t)(t + 1) * kstep;
            const char* a2 = last ? nA : cA + (size_t)(t + 2) * kstep; const char* b2 = last ? nB : cB + (size_t)(t + 2) * kstep;
            const char* a3 = a2 + kstep; const char* b3 = b2 + kstep;
            if (last && has_next) S.a_ready(nxt);
            if constexpr (Epi::SSPRE) { if (last && wid < 4) __builtin_amdgcn_global_load_lds((const unsigned*)(E.SS + cur.pm * BM + wid * 64 + lane), (PG8_LAS unsigned*)(lds + SSLDS_OFF + wid * 256), 4, 0, 0); }
            if constexpr (SP2) {
            PG8_LDB(B0, 0, 0); PG8_LDB(B1, 0, 1); PG8_SCHED; PG8_LDA(At, 0, 0); PG8_STAGE(PG8_SA(1, 1), a1 + hstep, voffA);
            PG8_WAIT_V(8); PG8_WAIT_L(0); PG8_BAR; PG8_MMA(0, 0, At, B0); PG8_MMA(0, 1, At, B1); PG8_BAR; PG8_SCHED;
            PG8_LDA(At, 0, 1); PG8_STAGE(PG8_SB(0, 0), b2, voffB); PG8_STAGE(PG8_SB(0, 1), b2 + hstep, voffB); PG8_STAGE(PG8_SA(0, 0), a2, voffA);
            PG8_WAIT_V(8); PG8_WAIT_L(0); PG8_BAR; PG8_MMA(1, 0, At, B0); PG8_MMA(1, 1, At, B1); PG8_BAR; PG8_SCHED;
            PG8_LDB(B0, 1, 0); PG8_LDB(B1, 1, 1); PG8_SCHED; PG8_LDA(At, 1, 0); PG8_STAGE(PG8_SA(0, 1), a2 + hstep, voffA);
            PG8_WAIT_V(8); PG8_WAIT_L(0); PG8_BAR; PG8_MMA(0, 0, At, B0); PG8_MMA(0, 1, At, B1); PG8_BAR; PG8_SCHED;
            PG8_LDA(At, 1, 1); PG8_STAGE(PG8_SB(1, 0), b3, voffB); PG8_STAGE(PG8_SB(1, 1), b3 + hstep, voffB); PG8_STAGE(PG8_SA(1, 0), a3, voffA);
            PG8_WAIT_V(8); PG8_WAIT_L(0); PG8_BAR; PG8_MMA(1, 0, At, B0); PG8_MMA(1, 1, At, B1); PG8_BAR; PG8_SCHED;
            } else {
            PG8_LDB(B0, 0, 0); PG8_SCHED; PG8_LDA(At, 0, 0); PG8_STAGE(PG8_SA(1, 1), a1 + hstep, voffA);
            PG8_WAIT_L(8); PG8_BAR; PG8_WAIT_L(0); PG8_MMA(0, 0, At, B0); PG8_BAR; PG8_SCHED;
            PG8_LDB(B1, 0, 1); PG8_STAGE(PG8_SB(0, 0), b2, voffB);
            PG8_BAR; PG8_WAIT_L(0); PG8_MMA(0, 1, At, B1); PG8_BAR;
            PG8_LDA(At, 0, 1); PG8_STAGE(PG8_SA(0, 0), a2, voffA);
            PG8_BAR; PG8_WAIT_L(0); PG8_MMA(1, 0, At, B0); PG8_BAR; PG8_SCHED;
            PG8_STAGE(PG8_SB(0, 1), b2 + hstep, voffB);
            PG8_WAIT_V(6); PG8_BAR; PG8_MMA(1, 1, At, B1); PG8_BAR;
            PG8_LDB(B0, 1, 0); PG8_SCHED; PG8_LDA(At, 1, 0); PG8_STAGE(PG8_SA(0, 1), a2 + hstep, voffA);
            PG8_WAIT_L(8); PG8_BAR; PG8_WAIT_L(0); PG8_MMA(0, 0, At, B0); PG8_BAR; PG8_SCHED;
            PG8_LDB(B1, 1, 1); PG8_STAGE(PG8_SB(1, 0), b3, voffB);
            PG8_BAR; PG8_WAIT_L(0); PG8_MMA(0, 1, At, B1); PG8_BAR;
            PG8_LDA(At, 1, 1); PG8_STAGE(PG8_SA(1, 0), a3, voffA);
            PG8_BAR; PG8_WAIT_L(0); PG8_MMA(1, 0, At, B0); PG8_BAR; PG8_SCHED;
            PG8_STAGE(PG8_SB(1, 1), b3 + hstep, voffB);
            PG8_WAIT_V(6); PG8_BAR; PG8_MMA(1, 1, At, B1); PG8_BAR;
            }
        }
        if constexpr (ALIGN_EPI) { if (wr == 0) PG8_BAR; }
        if constexpr (!Epi::AFTER_DRAIN) { E(acc, cur, wr, wc, fr, fq); S.done(cur); }
        if (!has_next) break;
#pragma unroll
        for (int a = 0; a < 2; ++a)
#pragma unroll
            for (int b = 0; b < 2; ++b)
#pragma unroll
                for (int m = 0; m < 4; ++m)
#pragma unroll
                    for (int n = 0; n < 2; ++n) acc[a][b][m][n] = (f32x4){0.f, 0.f, 0.f, 0.f};
        cur = nxt; cA = nA; cB = nB; ++ui;
        if constexpr (ALIGN_EPI) { if (wr == 1) PG8_BAR; }
    }
    PG8_WAIT_V(0);
    if constexpr (!ALIGN_EPI) { if (wr == 0) PG8_BAR; }
    PG8_BAR;
    if constexpr (Epi::AFTER_DRAIN) { E.fused(acc, cur, wr, wc, fr, fq, lds, wid, lane); S.done(cur); }
#undef PG8_SA
#undef PG8_SB
#undef PG8_STAGE
#undef PG8_LDA
#undef PG8_LDB
#undef PG8_MMA
#undef PG8_WAIT_V
#undef PG8_WAIT_L
#undef PG8_BAR
#undef PG8_SCHED
}
}
#define GAS __attribute__((address_space(1)))
#define LAS __attribute__((address_space(3)))
typedef unsigned short bf16;
typedef unsigned v4u __attribute__((ext_vector_type(4)));
typedef unsigned v2u __attribute__((ext_vector_type(2)));
typedef float f32x4 __attribute__((ext_vector_type(4)));
typedef float f32x2 __attribute__((ext_vector_type(2)));
typedef float f32x16 __attribute__((ext_vector_type(16)));
typedef short bf16x8 __attribute__((ext_vector_type(8)));
using pg8::pk_bf16; using pg8::bf_lo; using pg8::bf_hi; using pg8::sigmoid_fast;

constexpr int NWAVES = 8, NTHREADS = NWAVES * 64;
constexpr int BATCH = 4, SEQ = 4096, D = 2048, FF = 5632, M = BATCH * SEQ;
constexpr int S5G = 128, S5H = 16, S5P = 64, CHUNK = 64, NCH = SEQ / CHUNK;
constexpr int NH = 16, HD = 128, NQKV = 3 * D;
constexpr float EPS = 1e-6f;
constexpr size_t MiB = 1u << 20;
constexpr size_t WS_WGU = 0, WGU_BYTES = 44 * MiB, WD_BYTES = 22 * MiB, FFN_SET_BYTES = 66 * MiB;
constexpr size_t WS_WIN = 264 * MiB, WS_WGLU = 272 * MiB, WS_WOUT = 280 * MiB, WS_WQKV = 288 * MiB, WS_WO = 312 * MiB;
constexpr size_t WS_H = 320 * MiB;
constexpr size_t WS_BIG = 384 * MiB;
constexpr size_t WS_T1 = 576 * MiB;
constexpr size_t WS_T2 = 640 * MiB;
constexpr size_t WS_E = 704 * MiB;
constexpr size_t WS_BAR = 720 * MiB;
constexpr size_t WS_SS = 721 * MiB;
constexpr size_t WS_END = 722 * MiB;
constexpr int LDS_BYTES = 147456;
constexpr int LDS_MISC = 147456 - 256;

struct Params { const float* in[26]; float* out; unsigned char* ws; int ph_lo, ph_hi; };
enum { I_X = 0, I_NF1, I_F1G, I_F1U, I_F1D, I_NMIX, I_WIN, I_LRE, I_LIM, I_LDT, I_BRE, I_BIM, I_CRE, I_CIM, I_DSK, I_WGLU, I_BGLU, I_WOUT, I_WQKV, I_GQ, I_GK, I_WO, I_NF2, I_F2G, I_F2U, I_F2D };

#define LDS_WAIT() asm volatile("s_waitcnt lgkmcnt(0)" ::: "memory")

__device__ __forceinline__ void cvt_item(const float* W, int K, int N, bf16* WT, int mode, LAS float* scr, int item, int lane, const float* gain = nullptr) {
    const int nblk = N / 32, kb = item / nblk, nb = item % nblk, k0 = 64 * kb, n0 = 32 * nb;
    const int r0 = (mode == 0) ? n0 : ((n0 >> 7) * 256 + (mode == 2 ? 128 : 0) + (n0 & 127));
#pragma unroll 8
    for (int i = 0; i < 32; ++i) { const int kk = 2 * i + (lane >> 5); scr[kk * 33 + (lane & 31)] = W[(size_t)(k0 + kk) * N + n0 + (lane & 31)]; }
    LDS_WAIT();
    const int c = lane & 7;
    f32x4 ga = {1.f, 1.f, 1.f, 1.f}, gb = ga; if (gain) { ga = *(const f32x4*)(gain + k0 + 8 * c); gb = *(const f32x4*)(gain + k0 + 8 * c + 4); }
#pragma unroll
    for (int j = 0; j < 4; ++j) { const int n = (lane >> 3) + 8 * j; const LAS float* s = scr + (8 * c) * 33 + n;
        v4u o; o.x = pk_bf16(s[0 * 33] * ga.x, s[1 * 33] * ga.y); o.y = pk_bf16(s[2 * 33] * ga.z, s[3 * 33] * ga.w); o.z = pk_bf16(s[4 * 33] * gb.x, s[5 * 33] * gb.y); o.w = pk_bf16(s[6 * 33] * gb.z, s[7 * 33] * gb.w);
        *(v4u*)(WT + (size_t)(r0 + n) * K + k0 + 8 * c) = o; }
    LDS_WAIT();
}
__device__ __forceinline__ float wave_sum(float v) {
#pragma unroll
    for (int o = 1; o < 64; o <<= 1) v += __shfl_xor(v, o);
    return v;
}
__device__ __forceinline__ void norm_row(const float* xrow, const float* gain, bf16* orow, int lane) {
    const f32x4* xr = (const f32x4*)xrow + lane; const f32x4* gr = (const f32x4*)gain + lane;
    f32x4 v[8]; float s = 0.f;
#pragma unroll
    for (int j = 0; j < 8; ++j) { v[j] = xr[64 * j]; s += (v[j].x * v[j].x + v[j].y * v[j].y) + (v[j].z * v[j].z + v[j].w * v[j].w); }
    const float rstd = 1.0f / sqrtf(wave_sum(s) * (1.f / D) + EPS);
    v2u* o8 = (v2u*)orow + lane;
#pragma unroll
    for (int j = 0; j < 8; ++j) { const f32x4 g = gr[64 * j]; v2u w; w.x = pk_bf16(v[j].x * rstd * g.x, v[j].y * rstd * g.y); w.y = pk_bf16(v[j].z * rstd * g.z, v[j].w * rstd * g.w); o8[64 * j] = w; }
}
__device__ __forceinline__ void norm_phase(const float* X, const float* gain, bf16* H, int gw, int NGW, int lane) {
    for (int m = gw; m < M; m += NGW) norm_row(X + (size_t)m * D, gain, H + (size_t)m * D, lane);
}
__device__ __forceinline__ void p0_phase(const Params& P, LAS unsigned char* lds, int gw, int NGW, int wave, int lane) {
    LAS float* scr = (LAS float*)(lds + wave * 16384);
    constexpr int I_G = (D / 64) * (FF / 32), I_DN = (FF / 64) * (D / 32), I_SET = 2 * I_G + I_DN;
    constexpr int I_SQ = (D / 64) * (D / 32), I_QKV = (D / 64) * (NQKV / 32);
    constexpr int NITEMS = 4 * I_SET + 4 * I_SQ + I_QKV;
    unsigned char* ws = P.ws;
    for (int it = gw; it < NITEMS; it += NGW) {
        int r = it;
        if (r < 4 * I_SET) { const int set = r / I_SET; r -= set * I_SET; const int layer = set >> 1, second = set & 1;
            bf16* wgu = (bf16*)(ws + WS_WGU + (size_t)set * FFN_SET_BYTES); bf16* wd = (bf16*)(ws + WS_WGU + (size_t)set * FFN_SET_BYTES + WGU_BYTES);
            const float* g = P.in[second ? I_F2G : I_F1G] + (size_t)layer * D * FF; const float* u = P.in[second ? I_F2U : I_F1U] + (size_t)layer * D * FF; const float* dn = P.in[second ? I_F2D : I_F1D] + (size_t)layer * FF * D;
            const float* gn = P.in[second ? I_NF2 : I_NF1] + layer * D;
            if (r < I_G) { cvt_item(g, D, FF, wgu, 1, scr, r, lane, gn); continue; } r -= I_G;
            if (r < I_G) { cvt_item(u, D, FF, wgu, 2, scr, r, lane, gn); continue; } r -= I_G;
            cvt_item(dn, FF, D, wd, 0, scr, r, lane); continue; }
        r -= 4 * I_SET;
        if (r < I_SQ) { cvt_item(P.in[I_WIN], D, D, (bf16*)(ws + WS_WIN), 0, scr, r, lane, P.in[I_NMIX]); continue; } r -= I_SQ;
        if (r < I_SQ) { cvt_item(P.in[I_WGLU], D, D, (bf16*)(ws + WS_WGLU), 0, scr, r, lane); continue; } r -= I_SQ;
        if (r < I_SQ) { cvt_item(P.in[I_WOUT], D, D, (bf16*)(ws + WS_WOUT), 0, scr, r, lane); continue; } r -= I_SQ;
        if (r < I_SQ) { cvt_item(P.in[I_WO], D, D, (bf16*)(ws + WS_WO), 0, scr, r, lane); continue; } r -= I_SQ;
        cvt_item(P.in[I_WQKV], D, NQKV, (bf16*)(ws + WS_WQKV), 0, scr, r, lane, P.in[I_NMIX] + D);
    }
    float* SS = (float*)(ws + WS_SS);
    for (int i = gw * 64 + lane; i < 6 * M; i += NGW * 64) SS[M + i] = 0.f;
    for (int m = gw; m < M; m += NGW) {
        const f32x4* xr = (const f32x4*)(P.in[I_X] + (size_t)m * D) + lane; v2u* o8 = (v2u*)((bf16*)(ws + WS_H) + (size_t)m * D) + lane; float s = 0.f;
#pragma unroll
        for (int j = 0; j < 8; ++j) { const f32x4 v = xr[64 * j]; s += (v.x * v.x + v.y * v.y) + (v.z * v.z + v.w * v.w); v2u w; w.x = pk_bf16(v.x, v.y); w.y = pk_bf16(v.z, v.w); o8[64 * j] = w; }
        s = wave_sum(s); if (lane == 0) ((unsigned*)SS)[m] = (unsigned)(s * 4096.0f + 0.5f); }
}

__device__ __forceinline__ void sincos_acc(float x, float& s, float& c) {
    const float jf = rintf(x * 0.636619772f); const int j = (int)jf;
    float y = fmaf(-jf, 1.5703125f, x); y = fmaf(-jf, 4.837512969970703125e-4f, y); y = fmaf(-jf, 7.54978995489188216e-8f, y);
    const float z = y * y;
    const float sp = fmaf(fmaf(fmaf(-1.9515295891e-4f, z, 8.3321608736e-3f), z, -1.6666654611e-1f) * z, y, y);
    const float cp = fmaf(fmaf(fmaf(2.443315711809948e-5f, z, -1.388731625493765e-3f), z, 4.166664568298827e-2f), z * z, fmaf(-0.5f, z, 1.0f));
    const int q = j & 3;
    const float ss = (q & 1) ? cp : sp, cc = (q & 1) ? sp : cp;
    s = (q & 2) ? -ss : ss; c = ((q + 1) & 2) ? -cc : cc;
}
__device__ __forceinline__ void s5_setup(const Params& P, int g, int p, float& are, float& aim, f32x2 (&bb)[16]) {
    const float dt = expf(P.in[I_LDT][g]);
    const float lr = fminf(P.in[I_LRE][g * S5P + p], -1e-4f), li = P.in[I_LIM][g * S5P + p];
    const float mag = expf(lr * dt); float sn, cs; sincos_acc(li * dt, sn, cs);
    are = mag * cs; aim = mag * sn;
    const float den = lr * lr + li * li, nre = are - 1.0f;
    const float fre = (nre * lr + aim * li) / den, fim = (aim * lr - nre * li) / den;
    const f32x4* br = (const f32x4*)(P.in[I_BRE] + (size_t)(g * S5P + p) * S5H); const f32x4* bi = (const f32x4*)(P.in[I_BIM] + (size_t)(g * S5P + p) * S5H);
#pragma unroll
    for (int q = 0; q < 4; ++q) { const f32x4 r4 = br[q], i4 = bi[q];
#pragma unroll
        for (int e = 0; e < 4; ++e) { bb[4 * q + e].x = fre * r4[e] - fim * i4[e]; bb[4 * q + e].y = fre * i4[e] + fim * r4[e]; } }
}
__device__ __forceinline__ void s5_load_u(const float* U, int row0, int g, int lane, f32x4 (&pre)[4]) {
    const f32x4* src = (const f32x4*)(U + (size_t)(row0 + lane) * D + g * S5H);
    pre[0] = src[0]; pre[1] = src[1]; pre[2] = src[2]; pre[3] = src[3];
}
__device__ __forceinline__ void s5_put_u(LAS float* ubuf, int lane, const f32x4 (&pre)[4]) {
    LAS f32x4* dst = (LAS f32x4*)(ubuf + lane * 16);
    dst[0] = pre[0]; dst[1] = pre[1]; dst[2] = pre[2]; dst[3] = pre[3];
    LDS_WAIT();
}
__device__ __forceinline__ void s5_step(const LAS float* urow, const f32x2 (&bb)[16], float are, float aim, float& sre, float& sim) {
    const LAS f32x4* u4 = (const LAS f32x4*)urow;
    f32x2 bu = {0.f, 0.f};
#pragma unroll
    for (int q = 0; q < 4; ++q) { const f32x4 uu = u4[q];
#pragma unroll
        for (int e = 0; e < 4; ++e) { const f32x2 ub = {uu[e], uu[e]}; bu += bb[4 * q + e] * ub; } }
    const float nre = fmaf(are, sre, fmaf(-aim, sim, bu.x)), nim = fmaf(are, sim, fmaf(aim, sre, bu.y));
    sre = nre; sim = nim;
}
template <bool STORE>
__device__ __forceinline__ void s5_step4(const LAS float* urow, const f32x2 (&bb)[16], float are, float aim, float& sre, float& sim, LAS unsigned char* sw) {
    f32x4 uu[4][4];
#pragma unroll
    for (int s = 0; s < 4; ++s)
#pragma unroll
        for (int q = 0; q < 4; ++q) uu[s][q] = ((const LAS f32x4*)(urow + s * 16))[q];
    f32x2 acc[4][2];
#pragma unroll
    for (int s = 0; s < 4; ++s) { acc[s][0] = (f32x2){0.f, 0.f}; acc[s][1] = (f32x2){0.f, 0.f}; }
#pragma unroll
    for (int q = 0; q < 4; ++q)
#pragma unroll
        for (int e = 0; e < 4; ++e)
#pragma unroll
            for (int s = 0; s < 4; ++s) { const float uv = uu[s][q][e]; const f32x2 ub = {uv, uv}; acc[s][e & 1] += bb[4 * q + e] * ub; }
#pragma unroll
    for (int s = 0; s < 4; ++s) { const f32x2 bu = acc[s][0] + acc[s][1];
        const float nre = fmaf(are, sre, fmaf(-aim, sim, bu.x)), nim = fmaf(are, sim, fmaf(aim, sre, bu.y)); sre = nre; sim = nim;
        if (STORE) *(LAS unsigned*)(sw + s * 272) = pk_bf16(sre, sim); }
}
constexpr int NQ = 4, QLEN = SEQ / NQ, CPQ = QLEN / CHUNK;
__device__ __forceinline__ void s5_pass_a(const Params& P, LAS unsigned char* lds, int gw, int NGW, int wave, int lane) {
    LAS float* ubuf = (LAS float*)(lds + wave * 16384);
    const float* U = (const float*)(P.ws + WS_BIG); f32x2* E = (f32x2*)(P.ws + WS_E);
    for (int task = gw; task < BATCH * S5G * (NQ - 1); task += NGW) {
        const int g = task % S5G, b = (task / S5G) % BATCH, q = task / (S5G * BATCH);
        float are, aim; f32x2 bb[16]; s5_setup(P, g, lane, are, aim, bb);
        float sre = 0.f, sim = 0.f;
        f32x4 pre[4]; s5_load_u(U, b * SEQ + q * QLEN, g, lane, pre);
#pragma unroll 1
        for (int c = 0; c < CPQ; ++c) {
            s5_put_u(ubuf, lane, pre);
            s5_load_u(U, b * SEQ + q * QLEN + (c + 1 < CPQ ? c + 1 : c) * CHUNK, g, lane, pre);
#pragma unroll 2
            for (int t = 0; t < CHUNK; t += 4) s5_step4<false>(ubuf + t * 16, bb, are, aim, sre, sim, nullptr);
            LDS_WAIT();
        }
        E[((size_t)(b * NQ + q) * S5G + g) * S5P + lane] = (f32x2){sre, sim};
    }
}
__device__ __forceinline__ float gelu_tanh(float y) { const float z = 0.7978845608028654f * (y + 0.044715f * y * y * y); return y * sigmoid_fast(2.0f * z); }
__device__ __forceinline__ void s5_pass_b(const Params& P, LAS unsigned char* lds, int gw, int NGW, int wave, int lane) {
    LAS float* ubuf = (LAS float*)(lds + wave * 16384);
    LAS unsigned char* sbuf = lds + wave * 16384 + 4096;
    const float* U = (const float*)(P.ws + WS_BIG); const f32x2* E = (const f32x2*)(P.ws + WS_E); bf16* Y = (bf16*)(P.ws + WS_T1);
    const int fr = lane & 15, fq = lane >> 4;
    for (int task = gw; task < BATCH * S5G * NQ; task += NGW) {
        const int g = task % S5G, b = (task / S5G) % BATCH, q = task / (S5G * BATCH);
        float are, aim; f32x2 bb[16]; s5_setup(P, g, lane, are, aim, bb);
        float aqr = are, aqi = aim;
#pragma unroll
        for (int i = 0; i < 10; ++i) { const float nr = aqr * aqr - aqi * aqi, ni = 2.0f * aqr * aqi; aqr = nr; aqi = ni; }
        float sre = 0.f, sim = 0.f;
        for (int q2 = 0; q2 < q; ++q2) { const f32x2 e = E[((size_t)(b * NQ + q2) * S5G + g) * S5P + lane];
            const float nr = fmaf(aqr, sre, fmaf(-aqi, sim, e.x)), ni = fmaf(aqr, sim, fmaf(aqi, sre, e.y)); sre = nr; sim = ni; }
        bf16x8 ac[4];
#pragma unroll
        for (int ks = 0; ks < 4; ++ks) { const f32x4 cr = *(const f32x4*)(P.in[I_CRE] + (size_t)(g * S5H + fr) * S5P + 16 * ks + 4 * fq), ci = *(const f32x4*)(P.in[I_CIM] + (size_t)(g * S5H + fr) * S5P + 16 * ks + 4 * fq);
            v4u w; w.x = pk_bf16(cr.x, -ci.x); w.y = pk_bf16(cr.y, -ci.y); w.z = pk_bf16(cr.z, -ci.z); w.w = pk_bf16(cr.w, -ci.w); ac[ks] = __builtin_bit_cast(bf16x8, w); }
        const f32x4 dsk = *(const f32x4*)(P.in[I_DSK] + g * S5H + 4 * fq);
        f32x4 pre[4]; s5_load_u(U, b * SEQ + q * QLEN, g, lane, pre);
#pragma unroll 1
        for (int c = 0; c < CPQ; ++c) {
            const int row0 = b * SEQ + q * QLEN + c * CHUNK;
            s5_put_u(ubuf, lane, pre);
            s5_load_u(U, b * SEQ + q * QLEN + (c + 1 < CPQ ? c + 1 : c) * CHUNK, g, lane, pre);
#pragma unroll 1
            for (int half = 0; half < 2; ++half) {
#pragma unroll 2
                for (int tt = 0; tt < 32; tt += 4) s5_step4<true>(ubuf + (half * 32 + tt) * 16, bb, are, aim, sre, sim, sbuf + tt * 272 + 4 * lane);
                LDS_WAIT();
#pragma unroll
                for (int tile = 0; tile < 2; ++tile) { f32x4 acc = {0.f, 0.f, 0.f, 0.f};
#pragma unroll
                    for (int ks = 0; ks < 4; ++ks) { const bf16x8 sb = *(const LAS bf16x8*)(sbuf + (tile * 16 + fr) * 272 + 64 * ks + 16 * fq);
                        acc = __builtin_amdgcn_mfma_f32_16x16x32_bf16(ac[ks], sb, acc, 0, 0, 0); }
                    const int t = half * 32 + tile * 16 + fr;
                    const f32x4 uu = *(const LAS f32x4*)(ubuf + t * 16 + 4 * fq);
                    v2u w; w.x = pk_bf16(gelu_tanh(acc[0] + dsk[0] * uu[0]), gelu_tanh(acc[1] + dsk[1] * uu[1])); w.y = pk_bf16(gelu_tanh(acc[2] + dsk[2] * uu[2]), gelu_tanh(acc[3] + dsk[3] * uu[3]));
                    *(v2u*)(Y + (size_t)(row0 + t) * D + g * S5H + 4 * fq) = w; }
                LDS_WAIT();
            }
        }
    }
}


constexpr int S5W = 17920, S5_UB = 0, S5_BU = 2048, S5_PLANE = 64 * 80, S5_SB = S5_BU + 2 * S5_PLANE;
static_assert(S5_SB + 16 * 272 <= S5W, "S5 LDS map");
__device__ __forceinline__ void s5_disc(const Params& P, int g, int p, float& are, float& aim, float& fre, float& fim) {
    const float dt = expf(P.in[I_LDT][g]);
    const float lr = fminf(P.in[I_LRE][g * S5P + p], -1e-4f), li = P.in[I_LIM][g * S5P + p];
    const float mag = expf(lr * dt); float sn, cs; sincos_acc(li * dt, sn, cs);
    are = mag * cs; aim = mag * sn;
    const float den = lr * lr + li * li, nre = are - 1.0f;
    fre = (nre * lr + aim * li) / den; fim = (aim * lr - nre * li) / den;
}
__device__ __forceinline__ void s5_bops(const Params& P, int g, int fr, int fq, bf16x8 (&bop)[8]) {
    const int hq = fq & 1; const bool live = fq < 2;
#pragma unroll
    for (int pb = 0; pb < 4; ++pb) { const int p = 16 * pb + fr;
        float are, aim, fre, fim; s5_disc(P, g, p, are, aim, fre, fim);
        const f32x4* br = (const f32x4*)(P.in[I_BRE] + (size_t)(g * S5P + p) * S5H + 8 * hq); const f32x4* bi = (const f32x4*)(P.in[I_BIM] + (size_t)(g * S5P + p) * S5H + 8 * hq);
        const f32x4 r0 = br[0], r1 = br[1], i0 = bi[0], i1 = bi[1];
        float re[8], im[8];
#pragma unroll
        for (int e = 0; e < 4; ++e) { re[e] = fre * r0[e] - fim * i0[e]; im[e] = fre * i0[e] + fim * r0[e]; re[4 + e] = fre * r1[e] - fim * i1[e]; im[4 + e] = fre * i1[e] + fim * r1[e]; }
        v4u wr, wi; wr.x = pk_bf16(re[0], re[1]); wr.y = pk_bf16(re[2], re[3]); wr.z = pk_bf16(re[4], re[5]); wr.w = pk_bf16(re[6], re[7]);
        wi.x = pk_bf16(im[0], im[1]); wi.y = pk_bf16(im[2], im[3]); wi.z = pk_bf16(im[4], im[5]); wi.w = pk_bf16(im[6], im[7]);
        if (!live) { wr = (v4u){0u, 0u, 0u, 0u}; wi = wr; }
        bop[2 * pb] = __builtin_bit_cast(bf16x8, wr); bop[2 * pb + 1] = __builtin_bit_cast(bf16x8, wi); }
}
__device__ __forceinline__ void s5_put_u_bf16(LAS unsigned char* ub, int lane, const f32x4 (&pre)[4]) {
    v4u a, b; a.x = pk_bf16(pre[0].x, pre[0].y); a.y = pk_bf16(pre[0].z, pre[0].w); a.z = pk_bf16(pre[1].x, pre[1].y); a.w = pk_bf16(pre[1].z, pre[1].w);
    b.x = pk_bf16(pre[2].x, pre[2].y); b.y = pk_bf16(pre[2].z, pre[2].w); b.z = pk_bf16(pre[3].x, pre[3].y); b.w = pk_bf16(pre[3].z, pre[3].w);
    *(LAS v4u*)(ub + lane * 32) = a; *(LAS v4u*)(ub + lane * 32 + 16) = b;
    LDS_WAIT();
}
__device__ __forceinline__ void s5_bu16(LAS unsigned char* wl, int t0, int fr, int fq, const bf16x8 (&bop)[8]) {
    v4u araw = *(const LAS v4u*)(wl + S5_UB + (t0 + fr) * 32 + 16 * (fq & 1)); if (fq >= 2) araw = (v4u){0u, 0u, 0u, 0u};
    const bf16x8 af = __builtin_bit_cast(bf16x8, araw);
    f32x4 acc[8];
#pragma unroll
    for (int nt = 0; nt < 8; ++nt) { acc[nt] = (f32x4){0.f, 0.f, 0.f, 0.f};
        acc[nt] = __builtin_amdgcn_mfma_f32_16x16x32_bf16(af, bop[nt], acc[nt], 0, 0, 0); }
    asm volatile("s_nop 15\n\ts_nop 15" : "+v"(acc[0]), "+v"(acc[1]), "+v"(acc[2]), "+v"(acc[3]), "+v"(acc[4]), "+v"(acc[5]), "+v"(acc[6]), "+v"(acc[7]) :: "memory");
#pragma unroll
    for (int nt = 0; nt < 8; ++nt) *(LAS f32x4*)(wl + S5_BU + (nt & 1) * S5_PLANE + (16 * (nt >> 1) + fr) * 80 + 16 * fq) = acc[nt];
    asm volatile("" :: "v"(af));
    LDS_WAIT();
}
template <bool STORE>
__device__ __forceinline__ void s5_scan16(LAS unsigned char* wl, int lane, float are, float aim, float& sre, float& sim) {
    f32x4 re4[4], im4[4];
#pragma unroll
    for (int q = 0; q < 4; ++q) { re4[q] = *(const LAS f32x4*)(wl + S5_BU + lane * 80 + 16 * q); im4[q] = *(const LAS f32x4*)(wl + S5_BU + S5_PLANE + lane * 80 + 16 * q); }
#pragma unroll
    for (int q = 0; q < 4; ++q)
#pragma unroll
        for (int e = 0; e < 4; ++e) { const float nre = fmaf(are, sre, fmaf(-aim, sim, re4[q][e])), nim = fmaf(are, sim, fmaf(aim, sre, im4[q][e])); sre = nre; sim = nim;
            if (STORE) *(LAS unsigned*)(wl + S5_SB + (4 * q + e) * 272 + 4 * lane) = pk_bf16(sre, sim); }
    LDS_WAIT();
}
__device__ __forceinline__ void s5_pass_a2(const Params& P, LAS unsigned char* lds, int gw, int NGW, int wave, int lane) {
    LAS unsigned char* wl = lds + wave * S5W;
    const float* U = (const float*)(P.ws + WS_BIG); f32x2* E = (f32x2*)(P.ws + WS_E);
    const int fr = lane & 15, fq = lane >> 4;
    for (int task = gw; task < BATCH * S5G * (NQ - 1); task += NGW) {
        const int g = task % S5G, b = (task / S5G) % BATCH, q = task / (S5G * BATCH);
        float are, aim, fre, fim; s5_disc(P, g, lane, are, aim, fre, fim);
        bf16x8 bop[8]; s5_bops(P, g, fr, fq, bop);
        float sre = 0.f, sim = 0.f;
        f32x4 pre[4]; s5_load_u(U, b * SEQ + q * QLEN, g, lane, pre);
#pragma unroll 1
        for (int c = 0; c < CPQ; ++c) {
            s5_put_u_bf16(wl + S5_UB, lane, pre);
            s5_load_u(U, b * SEQ + q * QLEN + (c + 1 < CPQ ? c + 1 : c) * CHUNK, g, lane, pre);
#pragma unroll 1
            for (int blk = 0; blk < 4; ++blk) { s5_bu16(wl, 16 * blk, fr, fq, bop); s5_scan16<false>(wl, lane, are, aim, sre, sim); }
        }
        E[((size_t)(b * NQ + q) * S5G + g) * S5P + lane] = (f32x2){sre, sim};
    }
}
__device__ __forceinline__ void s5_pass_b2(const Params& P, LAS unsigned char* lds, int gw, int NGW, int wave, int lane) {
    LAS unsigned char* wl = lds + wave * S5W;
    const float* U = (const float*)(P.ws + WS_BIG); const f32x2* E = (const f32x2*)(P.ws + WS_E); bf16* Y = (bf16*)(P.ws + WS_T1);
    const int fr = lane & 15, fq = lane >> 4;
    for (int task = gw; task < BATCH * S5G * NQ; task += NGW) {
        const int g = task % S5G, b = (task / S5G) % BATCH, q = task / (S5G * BATCH);
        float are, aim, fre, fim; s5_disc(P, g, lane, are, aim, fre, fim);
        bf16x8 bop[8]; s5_bops(P, g, fr, fq, bop);
        float aqr = are, aqi = aim;
#pragma unroll
        for (int i = 0; i < 10; ++i) { const float nr = aqr * aqr - aqi * aqi, ni = 2.0f * aqr * aqi; aqr = nr; aqi = ni; }
        float sre = 0.f, sim = 0.f;
        for (int q2 = 0; q2 < q; ++q2) { const f32x2 e = E[((size_t)(b * NQ + q2) * S5G + g) * S5P + lane];
            const float nr = fmaf(aqr, sre, fmaf(-aqi, sim, e.x)), ni = fmaf(aqr, sim, fmaf(aqi, sre, e.y)); sre = nr; sim = ni; }
        bf16x8 ac[4];
#pragma unroll
        for (int ks = 0; ks < 4; ++ks) { const f32x4 cr = *(const f32x4*)(P.in[I_CRE] + (size_t)(g * S5H + fr) * S5P + 16 * ks + 4 * fq), ci = *(const f32x4*)(P.in[I_CIM] + (size_t)(g * S5H + fr) * S5P + 16 * ks + 4 * fq);
            v4u w; w.x = pk_bf16(cr.x, -ci.x); w.y = pk_bf16(cr.y, -ci.y); w.z = pk_bf16(cr.z, -ci.z); w.w = pk_bf16(cr.w, -ci.w); ac[ks] = __builtin_bit_cast(bf16x8, w); }
        const f32x4 dsk = *(const f32x4*)(P.in[I_DSK] + g * S5H + 4 * fq);
        f32x4 pre[4]; s5_load_u(U, b * SEQ + q * QLEN, g, lane, pre);
#pragma unroll 1
        for (int c = 0; c < CPQ; ++c) {
            const int row0 = b * SEQ + q * QLEN + c * CHUNK;
            s5_put_u_bf16(wl + S5_UB, lane, pre);
            s5_load_u(U, b * SEQ + q * QLEN + (c + 1 < CPQ ? c + 1 : c) * CHUNK, g, lane, pre);
#pragma unroll 1
            for (int blk = 0; blk < 4; ++blk) {
                s5_bu16(wl, 16 * blk, fr, fq, bop);
                s5_scan16<true>(wl, lane, are, aim, sre, sim);
                f32x4 acc = {0.f, 0.f, 0.f, 0.f};
#pragma unroll
                for (int ks = 0; ks < 4; ++ks) { const bf16x8 sb = *(const LAS bf16x8*)(wl + S5_SB + fr * 272 + 64 * ks + 16 * fq);
                    acc = __builtin_amdgcn_mfma_f32_16x16x32_bf16(ac[ks], sb, acc, 0, 0, 0); }
                asm volatile("s_nop 15" : "+v"(acc) :: "memory");
                const int t = 16 * blk + fr;
                const v2u ur = *(const LAS v2u*)(wl + S5_UB + t * 32 + 8 * fq);
                const float u0 = bf_lo(ur.x), u1 = bf_hi(ur.x), u2 = bf_lo(ur.y), u3 = bf_hi(ur.y);
                v2u w; w.x = pk_bf16(gelu_tanh(acc[0] + dsk[0] * u0), gelu_tanh(acc[1] + dsk[1] * u1)); w.y = pk_bf16(gelu_tanh(acc[2] + dsk[2] * u2), gelu_tanh(acc[3] + dsk[3] * u3));
                *(v2u*)(Y + (size_t)(row0 + t) * D + g * S5H + 4 * fq) = w;
                LDS_WAIT();
            }
        }
    }
}

__device__ __forceinline__ void sb_prep(const Params& P, LAS unsigned char* lds, int gw, int NGW, int wave, int lane) {
    bf16* QKV = (bf16*)(P.ws + WS_BIG); bf16* Vt = (bf16*)(P.ws + WS_T1);
    for (int task = gw; task < 2 * M; task += NGW) {
        const int m = task >> 1, which = task & 1;
        bf16* ptr = QKV + (size_t)m * NQKV + which * D + (lane >> 2) * HD + (lane & 3) * 32;
        const float* gain = P.in[which ? I_GK : I_GQ] + (lane & 3) * 32;
        v4u raw[4]; float v[32]; float ss = 0.f;
#pragma unroll
        for (int q = 0; q < 4; ++q) raw[q] = ((const v4u*)ptr)[q];
#pragma unroll
        for (int q = 0; q < 4; ++q)
#pragma unroll
            for (int e = 0; e < 4; ++e) { const unsigned w = raw[q][e]; v[8 * q + 2 * e] = bf_lo(w); v[8 * q + 2 * e + 1] = bf_hi(w); }
#pragma unroll
        for (int i = 0; i < 32; ++i) ss += v[i] * v[i];
        ss += __shfl_xor(ss, 1); ss += __shfl_xor(ss, 2);
        float rstd = 1.0f / sqrtf(ss * (1.f / HD) + EPS); if (!which) rstd *= 0.08838834764831845f;
#pragma unroll
        for (int q = 0; q < 4; ++q) { const f32x4 g0 = *(const f32x4*)(gain + 8 * q), g1 = *(const f32x4*)(gain + 8 * q + 4);
            v4u w; w.x = pk_bf16(v[8 * q] * rstd * g0.x, v[8 * q + 1] * rstd * g0.y); w.y = pk_bf16(v[8 * q + 2] * rstd * g0.z, v[8 * q + 3] * rstd * g0.w);
            w.z = pk_bf16(v[8 * q + 4] * rstd * g1.x, v[8 * q + 5] * rstd * g1.y); w.w = pk_bf16(v[8 * q + 6] * rstd * g1.z, v[8 * q + 7] * rstd * g1.w);
            ((v4u*)ptr)[q] = w; }
    }
    LAS unsigned char* tile = lds + wave * 16384;
    for (int task = gw; task < BATCH * NH * (SEQ / 32); task += NGW) {
        const int tb = task % (SEQ / 32), hh = (task / (SEQ / 32)) % NH, b = task / ((SEQ / 32) * NH);
#pragma unroll
        for (int i = 0; i < 8; ++i) { const int id = i * 64 + lane, tok = id >> 4, c = id & 15;
            const v4u x = *(const v4u*)(QKV + (size_t)(b * SEQ + tb * 32 + tok) * NQKV + 2 * D + hh * HD + c * 8);
            *(LAS v4u*)(tile + tok * 272 + c * 16) = x; }
        LDS_WAIT();
#pragma unroll
        for (int i = 0; i < 8; ++i) { const int id = i * 64 + lane, d = id >> 2, c = id & 3;
            unsigned short e[8];
#pragma unroll
            for (int j = 0; j < 8; ++j) e[j] = *(const LAS unsigned short*)(tile + (c * 8 + j) * 272 + d * 2);
            v4u w; w.x = e[0] | ((unsigned)e[1] << 16); w.y = e[2] | ((unsigned)e[3] << 16); w.z = e[4] | ((unsigned)e[5] << 16); w.w = e[6] | ((unsigned)e[7] << 16);
            *(v4u*)(Vt + ((size_t)((b * NH + hh) * HD + d)) * SEQ + tb * 32 + c * 8) = w; }
        LDS_WAIT();
    }
}
#define MFMA32(a, b, c) __builtin_amdgcn_mfma_f32_32x32x16_bf16((a), (b), (c), 0, 0, 0)
constexpr int AT_KSTR = 272, AT_VSTR = 72, AT_KBYTES = 32 * AT_KSTR, AT_WAVE_BYTES = AT_KBYTES + 128 * AT_VSTR;
__device__ __forceinline__ void sb_attn(const Params& P, LAS unsigned char* lds, int gw, int NGW, int wave, int lane) {
    const bf16* QKV = (const bf16*)(P.ws + WS_BIG); const bf16* Vt = (const bf16*)(P.ws + WS_T1); bf16* O = (bf16*)(P.ws + WS_T2);
    const int r = lane & 31, h = lane >> 5;
    LAS unsigned char* kbuf = lds + wave * AT_WAVE_BYTES; LAS unsigned char* vbuf = kbuf + AT_KBYTES;
    const int krow_l = lane >> 4, kc = lane & 15, vrow_l = lane >> 2, vc = lane & 3;
    for (int task = gw; task < BATCH * NH * (SEQ / 32); task += NGW) {
        const int qb = task % (SEQ / 32), hh = (task / (SEQ / 32)) % NH, b = task / ((SEQ / 32) * NH);
        const int q0 = 32 * qb, tq = q0 + r;
        const bf16* qrow = QKV + (size_t)(b * SEQ + q0 + r) * NQKV + hh * HD + 8 * h;
        bf16x8 qf[8];
#pragma unroll
        for (int s = 0; s < 8; ++s) qf[s] = *(const bf16x8*)(qrow + 16 * s);
        f32x16 o[4];
#pragma unroll
        for (int dt = 0; dt < 4; ++dt)
#pragma unroll
            for (int i = 0; i < 16; ++i) o[dt][i] = 0.f;
        float R = 0.f;
        const char* kbase = (const char*)(QKV + (size_t)(b * SEQ) * NQKV + D + hh * HD);
        const char* vbase = (const char*)(Vt + ((size_t)((b * NH + hh) * HD)) * SEQ);
        unsigned koff = (unsigned)(krow_l * NQKV + 8 * kc) * 2u, voff = (unsigned)(vrow_l * SEQ + 8 * vc) * 2u;
        asm volatile("" : "+v"(koff), "+v"(voff));
        v4u kraw[8], vraw[8];
#pragma unroll
        for (int i = 0; i < 8; ++i) { kraw[i] = *(const v4u*)(kbase + (size_t)(32 * qb + 4 * i) * (NQKV * 2) + koff); vraw[i] = *(const v4u*)(vbase + (size_t)(16 * i * SEQ + 32 * qb) * 2 + voff); }
        for (int kt = qb; kt >= 0; --kt) {
            const int k0 = 32 * kt;
#pragma unroll
            for (int i = 0; i < 8; ++i) { *(LAS v4u*)(kbuf + (4 * i + krow_l) * AT_KSTR + 16 * kc) = kraw[i];
                LAS v2u* vd = (LAS v2u*)(vbuf + (16 * i + vrow_l) * AT_VSTR + 16 * vc); vd[0] = (v2u){vraw[i].x, vraw[i].y}; vd[1] = (v2u){vraw[i].z, vraw[i].w}; }
            LDS_WAIT();
            { const int kn = kt > 0 ? kt - 1 : 0;
#pragma unroll
              for (int i = 0; i < 8; ++i) { kraw[i] = *(const v4u*)(kbase + (size_t)(32 * kn + 4 * i) * (NQKV * 2) + koff); vraw[i] = *(const v4u*)(vbase + (size_t)(16 * i * SEQ + 32 * kn) * 2 + voff); } }
            f32x16 x;
#pragma unroll
            for (int i = 0; i < 16; ++i) x[i] = 0.f;
#pragma unroll
            for (int s = 0; s < 8; ++s) { const bf16x8 kf = *(const LAS bf16x8*)(kbuf + r * AT_KSTR + 32 * s + 16 * h); x = MFMA32(kf, qf[s], x); }
            asm volatile("s_nop 7" ::: "memory");
            float lk[16], lb[16];
#pragma unroll
            for (int i = 0; i < 16; ++i) { const float z = x[i];
                const float sp = fmaxf(z, 0.f) + __builtin_amdgcn_logf(1.0f + __builtin_amdgcn_exp2f(-fabsf(z)));
                const int key = k0 + (i & 3) + 8 * (i >> 2) + 4 * h;
                lk[i] = (key < tq) ? -sp : 0.f; lb[i] = z - sp; }
            float gs[4], gp[4], e0[4], e1[4], e2[4];
#pragma unroll
            for (int g = 0; g < 4; ++g) { e2[g] = lk[4 * g + 3]; e1[g] = e2[g] + lk[4 * g + 2]; e0[g] = e1[g] + lk[4 * g + 1]; gs[g] = e0[g] + lk[4 * g]; gp[g] = __shfl_xor(gs[g], 32); }
            const float T0 = gs[0] + gp[0], T1 = gs[1] + gp[1], T2 = gs[2] + gp[2], T3 = gs[3] + gp[3];
            float base[4]; base[3] = R; base[2] = R + T3; base[1] = base[2] + T2; base[0] = base[1] + T1;
            const float total = (base[0] - R) + T0;
            float w[16];
#pragma unroll
            for (int g = 0; g < 4; ++g) { const float bg = base[g] + (h == 0 ? gp[g] : 0.f);
                const float s0 = bg + e0[g], s1 = bg + e1[g], s2 = bg + e2[g], s3 = bg;
                const int key = k0 + 8 * g + 4 * h;
                w[4 * g + 0] = (key + 0 < tq) ? __builtin_amdgcn_exp2f(lb[4 * g + 0] + s0) : 0.f;
                w[4 * g + 1] = (key + 1 < tq) ? __builtin_amdgcn_exp2f(lb[4 * g + 1] + s1) : 0.f;
                w[4 * g + 2] = (key + 2 < tq) ? __builtin_amdgcn_exp2f(lb[4 * g + 2] + s2) : 0.f;
                w[4 * g + 3] = (key + 3 < tq) ? __builtin_amdgcn_exp2f(lb[4 * g + 3] + s3) : 0.f; }
            R += total;
#pragma unroll
            for (int s = 0; s < 2; ++s) { v4u pw; pw.x = pk_bf16(w[8 * s], w[8 * s + 1]); pw.y = pk_bf16(w[8 * s + 2], w[8 * s + 3]); pw.z = pk_bf16(w[8 * s + 4], w[8 * s + 5]); pw.w = pk_bf16(w[8 * s + 6], w[8 * s + 7]);
                const bf16x8 xs = __builtin_bit_cast(bf16x8, pw);
#pragma unroll
                for (int dt = 0; dt < 4; ++dt) { const LAS unsigned char* vp = vbuf + (32 * dt + r) * AT_VSTR + 32 * s + 8 * h; const v2u lo = *(const LAS v2u*)vp, hi = *(const LAS v2u*)(vp + 16);
                    v4u pv; pv.x = lo.x; pv.y = lo.y; pv.z = hi.x; pv.w = hi.y;
                    o[dt] = MFMA32(__builtin_bit_cast(bf16x8, pv), xs, o[dt]); } }
            LDS_WAIT();
            if (__ballot(R > -152.0f) == 0ull) break;
        }
        asm volatile("s_nop 15" ::: "memory");
        bf16* orow = O + (size_t)(b * SEQ + q0 + r) * D + hh * HD + 4 * h;
#pragma unroll
        for (int dt = 0; dt < 4; ++dt)
#pragma unroll
            for (int g = 0; g < 4; ++g) { v2u w2; w2.x = pk_bf16(o[dt][4 * g], o[dt][4 * g + 1]); w2.y = pk_bf16(o[dt][4 * g + 2], o[dt][4 * g + 3]); *(v2u*)(orow + 32 * dt + 8 * g) = w2; }
    }
}

#define XB_TMO      128
#define XB_XCNT(j)  (256  + 64 * (j))
#define XB_XSUB(j)  (1280 + 64 * (j))
#define XB_XGEN(j)  (2304 + 64 * (j))
#define XB_TOP      3328
#define XB_TOPGEN   3392
#define XCD_BAR_WORDS 3456
#define XB_SPIN_CAP (1u << 18)

__device__ __forceinline__ unsigned xb_ld(unsigned* p)              { return __hip_atomic_load(p, __ATOMIC_RELAXED, __HIP_MEMORY_SCOPE_AGENT); }
__device__ __forceinline__ unsigned xb_add(unsigned* p, unsigned v) { return __hip_atomic_fetch_add(p, v, __ATOMIC_RELAXED, __HIP_MEMORY_SCOPE_AGENT); }
__device__ __forceinline__ unsigned xb_xcc_id() { return (unsigned)__builtin_amdgcn_s_getreg((3 << 11) | 20) & 0xFu; }
#define XB_SPIN(cond, bar) do { unsigned _sp = 0; while (cond) { __builtin_amdgcn_s_sleep(1); \
    if ((++_sp & 255u) == 0u) { if (xb_ld(&(bar)[XB_TMO])) break; if (_sp > XB_SPIN_CAP) { atomicAdd(&(bar)[XB_TMO], 1u); break; } } } } while (0)

struct XcdBarrier {
    unsigned* bar; unsigned x;
    volatile LAS unsigned* st;
};

__device__ __forceinline__ XcdBarrier xcd_barrier_post(unsigned* bar, volatile LAS unsigned* st) {
    XcdBarrier b; b.bar = bar; b.x = xb_xcc_id(); b.st = st;
    if (threadIdx.x == 0) (void)xb_add(&bar[XB_XCNT(b.x)], 1u);
    return b;
}
__device__ __forceinline__ void xcd_barrier_complete(unsigned* bar, unsigned x, unsigned& nloc, unsigned& nx) {
    const unsigned G = gridDim.x * gridDim.y * gridDim.z;
    unsigned sum, cnt, mine, sp = 0u;
    for (;;) {
        sum = 0u; cnt = 0u; mine = 0u;
#pragma unroll
        for (unsigned j = 0; j < 16; ++j) { const unsigned c = xb_ld(&bar[XB_XCNT(j)]); sum += c; cnt += (c > 0u) ? 1u : 0u; mine = (j == x) ? c : mine; }
        if (sum == G) break;
        __builtin_amdgcn_s_sleep(1);
        if ((++sp & 255u) == 0u) { if (xb_ld(&bar[XB_TMO])) break; if (sp > XB_SPIN_CAP) { atomicAdd(&bar[XB_TMO], 1u); break; } }
    }
    nloc = mine > 0u ? mine : 1u; nx = cnt > 0u ? cnt : 1u;
}

__device__ __forceinline__ void xcd_barrier(const XcdBarrier& b) {
    asm volatile("s_waitcnt vmcnt(0)" ::: "memory");
    __syncthreads();
    if (threadIdx.x == 0) {
        unsigned* bar = b.bar;
        __builtin_amdgcn_s_waitcnt(0);
        unsigned nloc = b.st[0], nx = b.st[1];
        if (nloc == 0u) { xcd_barrier_complete(bar, b.x, nloc, nx); b.st[0] = nloc; b.st[1] = nx; }
        const unsigned old = xb_add(&bar[XB_XSUB(b.x)], 1u);
        const unsigned gen = old / nloc;
        if (old + 1u == (gen + 1u) * nloc) {
            __builtin_amdgcn_fence(__ATOMIC_RELEASE, "agent");
            asm volatile("s_waitcnt vmcnt(0)" ::: "memory");
            const unsigned og = xb_add(&bar[XB_TOP], 1u);
            const unsigned tg = og / nx;
            if (og + 1u == (tg + 1u) * nx) xb_add(&bar[XB_TOPGEN], 1u);
            else XB_SPIN(xb_ld(&bar[XB_TOPGEN]) == tg, bar);
            __builtin_amdgcn_fence(__ATOMIC_ACQUIRE, "agent");
            xb_add(&bar[XB_XGEN(b.x)], 1u);
            asm volatile("s_waitcnt vmcnt(0)" ::: "memory");
        } else {
            XB_SPIN(xb_ld(&bar[XB_XGEN(b.x)]) == gen, bar);
            __builtin_amdgcn_fence(__ATOMIC_ACQUIRE, "agent");
            asm volatile("s_waitcnt vmcnt(0)" ::: "memory");
        }
    }
    __syncthreads();
}

constexpr int NPH = 17;
enum { T_P0 = 0, T_UP, T_DOWN, T_NORM, T_WIN, T_S5A, T_S5B, T_GLU, T_WOUT, T_QKV, T_PREP, T_ATTN, T_WO };
__global__ void __launch_bounds__(NTHREADS, 2) fwd_megakernel(Params P) {
    extern __shared__ __attribute__((aligned(16))) unsigned char lds_raw[];
    LAS unsigned char* lds = (LAS unsigned char*)lds_raw;
    cg::grid_group grid = cg::this_grid();
    volatile LAS unsigned* bst = (volatile LAS unsigned*)(lds + LDS_MISC);
    if (threadIdx.x < 4) bst[threadIdx.x] = 0u;
    __syncthreads();
    XcdBarrier xbar; xbar.bar = (unsigned*)(P.ws + WS_BAR); xbar.x = 0; xbar.st = bst;
    if (!MK_MULTI) xbar = xcd_barrier_post((unsigned*)(P.ws + WS_BAR), bst);
    for (int ph = P.ph_lo; ph < P.ph_hi; ++ph) {
        int tid = threadIdx.x; asm volatile("" : "+v"(tid));
        const int lane = tid & 63, wave = __builtin_amdgcn_readfirstlane(tid >> 6);
        const int G = gridDim.x, gw = blockIdx.x * NWAVES + wave, NGW = G * NWAVES;
        unsigned char* ws = P.ws;
        bf16* Hb = (bf16*)(ws + WS_H);
        int type, idx = 0;
        int ssi = 0, sso = 6;
        switch (ph) {
            case 0: type = T_P0; break;
            case 1: type = T_UP; idx = 0; ssi = 0; break;   case 2: type = T_DOWN; idx = 0; sso = 1; break;
            case 3: type = T_WIN; ssi = 1; break; case 4: type = T_S5A; break; case 5: type = T_S5B; break; case 6: type = T_GLU; break; case 7: type = T_WOUT; sso = 2; break;
            case 8: type = T_UP; idx = 1; ssi = 2; break;   case 9: type = T_DOWN; idx = 1; sso = 3; break;
            case 10: type = T_UP; idx = 2; ssi = 3; break;  case 11: type = T_DOWN; idx = 2; sso = 4; break;
            case 12: type = T_QKV; ssi = 4; break; case 13: type = T_ATTN; break; case 14: type = T_WO; sso = 5; break;
            case 15: type = T_UP; idx = 3; ssi = 5; break;  default: type = T_DOWN; idx = 3; break;
        }
        const float* SSi = (const float*)(ws + WS_SS) + (size_t)ssi * M; float* SSo = (float*)(ws + WS_SS) + (size_t)sso * M;
        if (type == T_P0) p0_phase(P, lds, gw, NGW, wave, lane);
        else if (type == T_UP) {
            pg8::Gemm g{Hb, (const bf16*)(ws + WS_WGU + (size_t)idx * FFN_SET_BYTES), M, 2 * FF, D}; pg8::StaticOrder S; S.init(M, 2 * FF, G, (int)blockIdx.x);
            pg8::EpiSwiGLU E{(bf16*)(ws + WS_BIG), FF, SSi, lds};
            pg8::gemm_phase<pg8::EpiSwiGLU, pg8::StaticOrder, true, true>(lds, g, S, E, tid);
        } else if (type == T_DOWN || type == T_WOUT || type == T_WO) {
            const bf16* A = type == T_DOWN ? (const bf16*)(ws + WS_BIG) : (const bf16*)(ws + WS_T2);
            const bf16* Bt = type == T_DOWN ? (const bf16*)(ws + WS_WGU + (size_t)idx * FFN_SET_BYTES + WGU_BYTES) : type == T_WOUT ? (const bf16*)(ws + WS_WOUT) : (const bf16*)(ws + WS_WO);
            const int K = type == T_DOWN ? FF : D;
            pg8::Gemm g{A, Bt, M, D, K}; pg8::StaticOrder S; S.init(M, D, G, (int)blockIdx.x, 4);
            pg8::EpiRes E{ph == NPH - 1 ? P.out : nullptr, D, type == T_DOWN ? 1 : 0, Hb, SSo};
            pg8::gemm_phase<pg8::EpiRes, pg8::StaticOrder, true, true>(lds, g, S, E, tid);
        } else if (type == T_WIN) {
            pg8::Gemm g{Hb, (const bf16*)(ws + WS_WIN), M, D, D}; pg8::StaticOrder S; S.init(M, D, G, (int)blockIdx.x);
            pg8::EpiF32 E{(float*)(ws + WS_BIG), D, SSi, lds};
            pg8::gemm_phase<pg8::EpiF32, pg8::StaticOrder, true, true>(lds, g, S, E, tid);
        } else if (type == T_S5A) s5_pass_a2(P, lds, gw, NGW, wave, lane);
        else if (type == T_S5B) s5_pass_b2(P, lds, gw, NGW, wave, lane);
        else if (type == T_GLU) {
            pg8::Gemm g{(const bf16*)(ws + WS_T1), (const bf16*)(ws + WS_WGLU), M, D, D}; pg8::StaticOrder S; S.init(M, D, G, (int)blockIdx.x);
            pg8::EpiGlu E{(const bf16*)(ws + WS_T1), (bf16*)(ws + WS_T2), D, P.in[I_BGLU]};
            pg8::gemm_phase<pg8::EpiGlu, pg8::StaticOrder, true, true>(lds, g, S, E, tid);
        } else if (type == T_QKV) {
            pg8::Gemm g{Hb, (const bf16*)(ws + WS_WQKV), M, NQKV, D}; pg8::StaticOrder S; S.init(M, NQKV, G, (int)blockIdx.x);
            pg8::EpiQKV E{(bf16*)(ws + WS_BIG), NQKV, SSi, lds, P.in[I_GQ], P.in[I_GK], (bf16*)(ws + WS_T1)};
            pg8::gemm_phase<pg8::EpiQKV, pg8::StaticOrder, true, true>(lds, g, S, E, tid);
        } else if (type == T_PREP) sb_prep(P, lds, gw, NGW, wave, lane);
        else if (type == T_ATTN) sb_attn(P, lds, gw, NGW, wave, lane);
        if (ph + 1 < P.ph_hi) { if (ph == 0) grid.sync(); else xcd_barrier(xbar); }
    }
}

extern "C" void kernel_launch(void* const* d_in, const int* in_sizes, int n_in, void* d_out, int out_size, void* d_ws, size_t ws_size, hipStream_t stream) {
    static int grid = 0;
    if (grid == 0) {
        if (n_in != 26 || in_sizes[0] != M * D || out_size != M * D || ws_size < WS_END) { fprintf(stderr, "kernel_launch: unexpected shapes (n_in %d, in0 %d, out %d, ws %zu)\n", n_in, n_in > 0 ? in_sizes[0] : -1, out_size, ws_size); grid = -1; return; }
        int dev = 0, cus = 0, per_cu = 0;
        if (hipGetDevice(&dev) != hipSuccess || hipDeviceGetAttribute(&cus, hipDeviceAttributeMultiprocessorCount, dev) != hipSuccess) { fprintf(stderr, "kernel_launch: device query failed\n"); grid = -1; return; }
        if (hipFuncSetAttribute((const void*)fwd_megakernel, hipFuncAttributeMaxDynamicSharedMemorySize, LDS_BYTES) != hipSuccess) { fprintf(stderr, "kernel_launch: hipFuncSetAttribute failed\n"); grid = -1; return; }
        if (hipOccupancyMaxActiveBlocksPerMultiprocessor(&per_cu, (const void*)fwd_megakernel, NTHREADS, LDS_BYTES) != hipSuccess || per_cu < 1) { fprintf(stderr, "kernel_launch: occupancy query says %d blocks per CU\n", per_cu); per_cu = 1; }
        (void)hipGetLastError();
        grid = cus * per_cu;
        fprintf(stderr, "kernel_launch: grid %d (%d CUs x %d)\n", grid, cus, per_cu);
    }
    if (grid < 0) return;
    Params p{};
    for (int i = 0; i < 26; ++i) p.in[i] = (const float*)d_in[i];
    p.out = (float*)d_out; p.ws = (unsigned char*)d_ws;
#if MK_MULTI
    for (int ph = 0; ph < NPH; ++ph) { p.ph_lo = ph; p.ph_hi = ph + 1;
        hipLaunchKernelGGL(fwd_megakernel, dim3(grid), dim3(NTHREADS), LDS_BYTES, stream, p);
        const hipError_t le = hipPeekAtLastError(); if (le != hipSuccess) { fprintf(stderr, "kernel_launch: launch %d failed: %s\n", ph, hipGetErrorName(le)); break; } }
#else
    p.ph_lo = 0; p.ph_hi = NPH;
    if (hipMemsetAsync((char*)d_ws + WS_BAR, 0, XCD_BAR_WORDS * 4, stream) != hipSuccess) { fprintf(stderr, "kernel_launch: memset failed\n"); return; }
    void* args[] = {&p};
    const hipError_t le = hipLaunchCooperativeKernel((const void*)fwd_megakernel, dim3(grid), dim3(NTHREADS), args, LDS_BYTES, stream);
    if (le != hipSuccess) fprintf(stderr, "kernel_launch: cooperative launch failed: %s (grid %d)\n", hipGetErrorString(le), grid);
#endif
}
```

```cpp
#include <hip/hip_runtime.h>
#include <hip/hip_cooperative_groups.h>
#include <cstdio>
#include <cstdint>
namespace cg = cooperative_groups;
#ifndef MK_MULTI
#define MK_MULTI 0
#endif
namespace pg8 {
#define PG8_LAS __attribute__((address_space(3)))
typedef unsigned short bf16_t;
typedef short bf16x8 __attribute__((ext_vector_type(8)));
typedef float f32x4 __attribute__((ext_vector_type(4)));
typedef unsigned u32x4 __attribute__((ext_vector_type(4)));
constexpr int BM = 256, BK = 64, HALF = 128, HTB = HALF * BK * 2  , STAGE_BYTES = 8 * HTB, NXCD = 8, WGM = 8;

__host__ __device__ __forceinline__ int lds_byte(int r, int c) { const int st = (r >> 4) * 2 + (c >> 5), rr = r & 15, cc = c & 31, ob = rr * 64 + cc * 2; return st * 1024 + (ob ^ (((ob >> 9) & 1) << 5)); }
__host__ __device__ __forceinline__ void stage_rc(int b, int& R, int& C) { const int st = b / 1024, sb = b % 1024, swz = sb ^ (((sb >> 9) & 1) << 5); R = (st >> 1) * 16 + swz / 64; C = (st & 1) * 32 + (swz % 64) / 2; }
__host__ __device__ __forceinline__ int perm32(int rho) { const int n = rho >> 4, i = rho & 15; return 8 * (i >> 2) + 4 * n + (i & 3); }

struct Unit { int pm, pn; };
struct Gemm { const bf16_t* A; const bf16_t* Bt; int M, N, K; };

struct StaticOrder {
    int nM, nN, nwg, G, c, wgm;
    __host__ __device__ void init(int M, int N, int G_, int c_, int wgm_ = WGM) { nM = M / BM; nN = N / BM; nwg = nM * nN; G = G_; c = c_; wgm = wgm_; }
    __host__ __device__ bool next(int i, Unit& u) const {
        const long L = (long)i * G + c; if (L >= nwg) return false;
        int wgid = (int)L; { const int q = nwg / NXCD, r = nwg % NXCD, xcd = wgid % NXCD, off = wgid / NXCD; wgid = (xcd < r ? xcd * (q + 1) : r * (q + 1) + (xcd - r) * q) + off; }
        const int nig = wgm * nN, gid = wgid / nig, fm = gid * wgm, gsz = (nM - fm) < wgm ? (nM - fm) : wgm;
        u.pm = fm + ((wgid % nig) % gsz); u.pn = (wgid % nig) / gsz; return true;
    }
    __device__ __forceinline__ void a_ready(const Unit&) const {}
    __device__ __forceinline__ void done(const Unit&) const {}
};
__device__ __forceinline__ unsigned cvt_pk_bf16(float lo, float hi) { unsigned r; asm volatile("v_cvt_pk_bf16_f32 %0, %1, %2" : "=v"(r) : "v"(lo), "v"(hi)); return r; }
typedef float f32x2 __attribute__((ext_vector_type(2)));
typedef __bf16 bf16x2_t __attribute__((ext_vector_type(2)));
__device__ __forceinline__ unsigned pk_bf16(float lo, float hi) { f32x2 v = {lo, hi}; bf16x2_t b = __builtin_convertvector(v, bf16x2_t); return __builtin_bit_cast(unsigned, b); }
__device__ __forceinline__ float bf_lo(unsigned w) { return __builtin_bit_cast(float, w << 16); }
__device__ __forceinline__ float bf_hi(unsigned w) { return __builtin_bit_cast(float, w & 0xffff0000u); }
__device__ __forceinline__ float sigmoid_fast(float v) { return __builtin_amdgcn_rcpf(1.0f + __builtin_amdgcn_exp2f(-1.44269504089f * v)); }
__device__ __forceinline__ float rstd_val(float ss) { return __builtin_amdgcn_rsqf(ss * (1.0f / 2048.0f) + 1e-6f); }
constexpr int SSLDS_OFF = 131072 + 1024;
struct EpiSwiGLU {
    static constexpr bool PERM = true, AFTER_DRAIN = false, SSPRE = true;
    bf16_t* O; int ldc; const float* SS; PG8_LAS unsigned char* LDSB;
    __device__ __forceinline__ void operator()(const f32x4 (&acc)[2][2][4][2], const Unit& u, int wr, int wc, int fr, int fq) const {
        const int row0 = u.pm * BM + wr * 64 + fr, col0 = u.pn * HALF + wc * 32 + 8 * fq;
        const PG8_LAS float* ssl = (const PG8_LAS float*)(LDSB + SSLDS_OFF);
        float rsv[2][4];
#pragma unroll
        for (int ai = 0; ai < 2; ++ai)
#pragma unroll
            for (int m = 0; m < 4; ++m) rsv[ai][m] = (float)((const PG8_LAS unsigned*)ssl)[ai * HALF + wr * 64 + m * 16 + fr] * (1.0f / 4096.0f);
#pragma unroll
        for (int ai = 0; ai < 2; ++ai)
#pragma unroll
            for (int m = 0; m < 4; ++m) { bf16_t* rowp = O + (size_t)(row0 + ai * HALF + m * 16) * ldc + col0;
                const float rs = rstd_val(rsv[ai][m]);
                float v[8];
#pragma unroll
                for (int n = 0; n < 2; ++n) {
                    const f32x4 g4 = acc[ai][0][m][n] * rs, u4 = acc[ai][1][m][n] * rs, a4 = g4 * (-1.44269504089f), p4 = g4 * u4;
                    f32x4 e4; e4[0] = __builtin_amdgcn_exp2f(a4[0]); e4[1] = __builtin_amdgcn_exp2f(a4[1]); e4[2] = __builtin_amdgcn_exp2f(a4[2]); e4[3] = __builtin_amdgcn_exp2f(a4[3]);
                    const f32x4 d4 = e4 + 1.0f;
                    f32x4 r4; r4[0] = __builtin_amdgcn_rcpf(d4[0]); r4[1] = __builtin_amdgcn_rcpf(d4[1]); r4[2] = __builtin_amdgcn_rcpf(d4[2]); r4[3] = __builtin_amdgcn_rcpf(d4[3]);
                    const f32x4 o4 = p4 * r4;
                    v[4 * n] = o4[0]; v[4 * n + 1] = o4[1]; v[4 * n + 2] = o4[2]; v[4 * n + 3] = o4[3]; }
                u32x4 w; w.x = pk_bf16(v[0], v[1]); w.y = pk_bf16(v[2], v[3]); w.z = pk_bf16(v[4], v[5]); w.w = pk_bf16(v[6], v[7]);
                *(u32x4*)rowp = w; }
    }
};
typedef unsigned u32x2v __attribute__((ext_vector_type(2)));
struct EpiRes {
    static constexpr bool PERM = true, AFTER_DRAIN = false, SSPRE = false;
    float* OUT; int ldc; int half; bf16_t* XB; float* SSo;
    __device__ __forceinline__ void operator()(const f32x4 (&acc)[2][2][4][2], const Unit& u, int wr, int wc, int fr, int fq) const {
        const int row0 = u.pm * BM + wr * 64 + fr, col0 = u.pn * BM + wc * 32 + 8 * fq;
        const float alpha = half ? 0.5f : 1.0f;
#pragma unroll
        for (int ai = 0; ai < 2; ++ai) {
            u32x4 rv[4][2];
#pragma unroll
            for (int m = 0; m < 4; ++m)
#pragma unroll
                for (int bj = 0; bj < 2; ++bj) rv[m][bj] = *(const u32x4*)(XB + (size_t)(row0 + ai * HALF + m * 16) * ldc + col0 + bj * HALF);
#pragma unroll
            for (int m = 0; m < 4; ++m) { const size_t off = (size_t)(row0 + ai * HALF + m * 16) * ldc + col0;
                float ssum = 0.f;
#pragma unroll
                for (int bj = 0; bj < 2; ++bj) { const u32x4 r = rv[m][bj];
                    const f32x4 v0 = (f32x4){bf_lo(r.x), bf_hi(r.x), bf_lo(r.y), bf_hi(r.y)} + acc[ai][bj][m][0] * alpha, v1 = (f32x4){bf_lo(r.z), bf_hi(r.z), bf_lo(r.w), bf_hi(r.w)} + acc[ai][bj][m][1] * alpha;
                    if (OUT) { *(f32x4*)(OUT + off + bj * HALF) = v0; *(f32x4*)(OUT + off + bj * HALF + 4) = v1; }
                    else { u32x4 w; w.x = pk_bf16(v0[0], v0[1]); w.y = pk_bf16(v0[2], v0[3]); w.z = pk_bf16(v1[0], v1[1]); w.w = pk_bf16(v1[2], v1[3]); *(u32x4*)(XB + off + bj * HALF) = w;
                        ssum += ((v0[0] * v0[0] + v0[1] * v0[1]) + (v0[2] * v0[2] + v0[3] * v0[3])) + ((v1[0] * v1[0] + v1[1] * v1[1]) + (v1[2] * v1[2] + v1[3] * v1[3])); } }
                if (!OUT) { ssum += __shfl_xor(ssum, 16); ssum += __shfl_xor(ssum, 32); if (fq == 0) atomicAdd((unsigned*)SSo + row0 + ai * HALF + m * 16, (unsigned)(ssum * 4096.0f + 0.5f)); } }
            asm volatile("" ::: "memory"); }
    }
};
struct EpiF32 {
    static constexpr bool PERM = false, AFTER_DRAIN = false, SSPRE = true;
    float* C; int ldc; const float* SS; PG8_LAS unsigned char* LDSB;
    __device__ __forceinline__ void operator()(const f32x4 (&acc)[2][2][4][2], const Unit& u, int wr, int wc, int fr, int fq) const {
        const int row0 = u.pm * BM + wr * 64 + fr, col0 = u.pn * BM + wc * 32 + 4 * fq;
        const PG8_LAS float* ssl = (const PG8_LAS float*)(LDSB + SSLDS_OFF);
        float rsv[2][4];
#pragma unroll
        for (int ai = 0; ai < 2; ++ai)
#pragma unroll
            for (int m = 0; m < 4; ++m) rsv[ai][m] = (float)((const PG8_LAS unsigned*)ssl)[ai * HALF + wr * 64 + m * 16 + fr] * (1.0f / 4096.0f);
#pragma unroll
        for (int ai = 0; ai < 2; ++ai)
#pragma unroll
            for (int m = 0; m < 4; ++m) { float* rowp = C + (size_t)(row0 + ai * HALF + m * 16) * ldc + col0; const float rs = rstd_val(rsv[ai][m]);
#pragma unroll
                for (int bj = 0; bj < 2; ++bj)
#pragma unroll
                    for (int n = 0; n < 2; ++n) *(f32x4*)(rowp + bj * HALF + n * 16) = acc[ai][bj][m][n] * rs; }
    }
};
struct EpiBf16 {
    static constexpr bool PERM = true, AFTER_DRAIN = false, SSPRE = true;
    bf16_t* O; int ldc; const float* SS; PG8_LAS unsigned char* LDSB;
    __device__ __forceinline__ void operator()(const f32x4 (&acc)[2][2][4][2], const Unit& u, int wr, int wc, int fr, int fq) const {
        const int row0 = u.pm * BM + wr * 64 + fr, col0 = u.pn * BM + wc * 32 + 8 * fq;
        const PG8_LAS float* ssl = (const PG8_LAS float*)(LDSB + SSLDS_OFF);
        float rsv[2][4];
#pragma unroll
        for (int ai = 0; ai < 2; ++ai)
#pragma unroll
            for (int m = 0; m < 4; ++m) rsv[ai][m] = (float)((const PG8_LAS unsigned*)ssl)[ai * HALF + wr * 64 + m * 16 + fr] * (1.0f / 4096.0f);
#pragma unroll
        for (int ai = 0; ai < 2; ++ai)
#pragma unroll
            for (int m = 0; m < 4; ++m) { bf16_t* rowp = O + (size_t)(row0 + ai * HALF + m * 16) * ldc + col0; const float rs = rstd_val(rsv[ai][m]);
#pragma unroll
                for (int bj = 0; bj < 2; ++bj) { const f32x4 v0 = acc[ai][bj][m][0] * rs, v1 = acc[ai][bj][m][1] * rs;
                    u32x4 w; w.x = pk_bf16(v0[0], v0[1]); w.y = pk_bf16(v0[2], v0[3]); w.z = pk_bf16(v1[0], v1[1]); w.w = pk_bf16(v1[2], v1[3]);
                    *(u32x4*)(rowp + bj * HALF) = w; } }
    }
};
constexpr int PART_OFF = 131072 + 2048;
struct EpiQKV {
    static constexpr bool PERM = true, AFTER_DRAIN = false, SSPRE = true;
    bf16_t* O; int ldc; const float* SS; PG8_LAS unsigned char* LDSB; const float* gq; const float* gk; bf16_t* Vt;
    __device__ __forceinline__ void operator()(const f32x4 (&acc)[2][2][4][2], const Unit& u, int wr, int wc, int fr, int fq) const {
        const int row0 = u.pm * BM + wr * 64 + fr, colt = u.pn * BM, which = colt >> 11;
        const PG8_LAS float* ssl = (const PG8_LAS float*)(LDSB + SSLDS_OFF);
        float rsv[2][4];
#pragma unroll
        for (int ai = 0; ai < 2; ++ai)
#pragma unroll
            for (int m = 0; m < 4; ++m) rsv[ai][m] = rstd_val((float)((const PG8_LAS unsigned*)ssl)[ai * HALF + wr * 64 + m * 16 + fr] * (1.0f / 4096.0f));
        if (which < 2) {
            PG8_LAS float* part = (PG8_LAS float*)(LDSB + PART_OFF);
#pragma unroll
            for (int ai = 0; ai < 2; ++ai)
#pragma unroll
                for (int m = 0; m < 4; ++m)
#pragma unroll
                    for (int bj = 0; bj < 2; ++bj) { const float rs = rsv[ai][m]; const f32x4 v0 = acc[ai][bj][m][0] * rs, v1 = acc[ai][bj][m][1] * rs;
                        float s = ((v0[0] * v0[0] + v0[1] * v0[1]) + (v0[2] * v0[2] + v0[3] * v0[3])) + ((v1[0] * v1[0] + v1[1] * v1[1]) + (v1[2] * v1[2] + v1[3] * v1[3]));
                        s += __shfl_xor(s, 16); s += __shfl_xor(s, 32);
                        if (fq == 0) part[((ai * HALF + wr * 64 + m * 16 + fr) * 2 + bj) * 4 + wc] = s; }
            asm volatile("s_waitcnt lgkmcnt(0)" ::: "memory"); __builtin_amdgcn_s_barrier(); asm volatile("" ::: "memory");
            const float* gn = (which ? gk : gq) + wc * 32 + 8 * fq; const f32x4 ga = *(const f32x4*)gn, gb = *(const f32x4*)(gn + 4);
            const float qs = which ? 1.0f : 0.08838834764831845f * 1.4426950408889634f;
#pragma unroll
            for (int ai = 0; ai < 2; ++ai)
#pragma unroll
                for (int m = 0; m < 4; ++m) { bf16_t* rowp = O + (size_t)(row0 + ai * HALF + m * 16) * ldc + colt + wc * 32 + 8 * fq;
#pragma unroll
                    for (int bj = 0; bj < 2; ++bj) { const f32x4 p4 = *(const PG8_LAS f32x4*)(part + ((ai * HALF + wr * 64 + m * 16 + fr) * 2 + bj) * 4);
                        const float hr = rsv[ai][m] * qs * __builtin_amdgcn_rsqf(((p4[0] + p4[1]) + (p4[2] + p4[3])) * (1.0f / 128.0f) + 1e-6f);
                        const f32x4 v0 = acc[ai][bj][m][0] * hr * ga, v1 = acc[ai][bj][m][1] * hr * gb;
                        u32x4 w; w.x = pk_bf16(v0[0], v0[1]); w.y = pk_bf16(v0[2], v0[3]); w.z = pk_bf16(v1[0], v1[1]); w.w = pk_bf16(v1[2], v1[3]);
                        *(u32x4*)(rowp + bj * HALF) = w; } }
        } else {
#pragma unroll
            for (int ai = 0; ai < 2; ++ai)
#pragma unroll
                for (int m = 0; m < 4; ++m) { const int row = row0 + ai * HALF + m * 16, b = row >> 12, tok = row & 4095; const float rs = rsv[ai][m];
#pragma unroll
                    for (int bj = 0; bj < 2; ++bj) { const int head = ((colt - 4096) >> 7) + bj;
                        bf16_t* vp = Vt + ((size_t)((b * 16 + head) * 128 + wc * 32 + 8 * fq)) * 4096 + tok;
#pragma unroll
                        for (int n = 0; n < 2; ++n)
#pragma unroll
                            for (int j = 0; j < 4; ++j) vp[(size_t)(4 * n + j) * 4096] = (bf16_t)(pk_bf16(acc[ai][bj][m][n][j] * rs, 0.f) & 0xffffu); } }
        }
    }
};
struct EpiGlu {
    static constexpr bool PERM = true, AFTER_DRAIN = false, SSPRE = false;
    const bf16_t* Y; bf16_t* O; int ldc; const float* bias;
    __device__ __forceinline__ void operator()(const f32x4 (&acc)[2][2][4][2], const Unit& u, int wr, int wc, int fr, int fq) const {
        const int row0 = u.pm * BM + wr * 64 + fr, col0 = u.pn * BM + wc * 32 + 8 * fq;
        f32x4 bv[2][2];
#pragma unroll
        for (int bj = 0; bj < 2; ++bj)
#pragma unroll
            for (int n = 0; n < 2; ++n) bv[bj][n] = *(const f32x4*)(bias + col0 + bj * HALF + 4 * n);
#pragma unroll
        for (int ai = 0; ai < 2; ++ai) {
            u32x4 yy[4][2];
#pragma unroll
            for (int m = 0; m < 4; ++m)
#pragma unroll
                for (int bj = 0; bj < 2; ++bj) yy[m][bj] = *(const u32x4*)(Y + (size_t)(row0 + ai * HALF + m * 16) * ldc + col0 + bj * HALF);
#pragma unroll
            for (int m = 0; m < 4; ++m) { const size_t off = (size_t)(row0 + ai * HALF + m * 16) * ldc + col0;
#pragma unroll
                for (int bj = 0; bj < 2; ++bj) { const u32x4 yv = yy[m][bj];
                    const f32x4 g0 = acc[ai][bj][m][0] + bv[bj][0], g1 = acc[ai][bj][m][1] + bv[bj][1];
                    u32x4 w;
                    w.x = pk_bf16(bf_lo(yv.x) * sigmoid_fast(g0[0]), bf_hi(yv.x) * sigmoid_fast(g0[1]));
                    w.y = pk_bf16(bf_lo(yv.y) * sigmoid_fast(g0[2]), bf_hi(yv.y) * sigmoid_fast(g0[3]));
                    w.z = pk_bf16(bf_lo(yv.z) * sigmoid_fast(g1[0]), bf_hi(yv.z) * sigmoid_fast(g1[1]));
                    w.w = pk_bf16(bf_lo(yv.w) * sigmoid_fast(g1[2]), bf_hi(yv.w) * sigmoid_fast(g1[3]));
                    *(u32x4*)(O + off + bj * HALF) = w; } }
            asm volatile("" ::: "memory"); }
    }
};
template <class Epi, class Sched, bool ALIGN_EPI = false, bool SP2 = false>
__device__ __forceinline__ void gemm_phase(PG8_LAS unsigned char* lds, const Gemm g, const Sched& S, const Epi& E, const int tid) {
    const int wid = __builtin_amdgcn_readfirstlane(tid >> 6), lane = tid & 63, wr = wid >> 2, wc = wid & 3, fr = lane & 15, fq = lane >> 4;
    const int K = g.K, nt = K / BK;
    unsigned voffA[2], voffB[2];
#pragma unroll
    for (int i = 0; i < 2; ++i) { int R, C; stage_rc(tid * 16 + i * 8192, R, C); const int Rb = Epi::PERM ? ((R & ~31) + perm32(R & 31)) : R;
        voffA[i] = (unsigned)(R * K + C) * 2u; voffB[i] = (unsigned)(Rb * K + C) * 2u; }
    const size_t kstep = (size_t)(BK * 2);
    const size_t hstep = (size_t)HALF * K * 2;
    const size_t tstep = 2 * hstep;
    const unsigned ldsw = (unsigned)wid * 1024u;
    const int aoff = lds_byte(wr * 64 + fr, fq * 8), boff = lds_byte(wc * 32 + fr, fq * 8);
#define PG8_SA(b, h) (((b) * 2 + (h)) * HTB)
#define PG8_SB(b, h) ((4 + (b) * 2 + (h)) * HTB)
#define PG8_STAGE(bufoff, gbase, voff) do { _Pragma("unroll") for (int _i = 0; _i < 2; ++_i) \
        __builtin_amdgcn_global_load_lds((const unsigned*)((const char*)(gbase) + (voff)[_i]), (PG8_LAS unsigned*)(lds + (bufoff) + ldsw + _i * 8192), 16, 0, 0); } while (0)
#define PG8_LDA(dst, b, h) do { _Pragma("unroll") for (int m = 0; m < 4; ++m) _Pragma("unroll") for (int k = 0; k < 2; ++k) dst[m][k] = *(const PG8_LAS bf16x8*)(lds + PG8_SA(b, h) + aoff + m * 2048 + k * 1024); } while (0)
#define PG8_LDB(dst, b, h) do { _Pragma("unroll") for (int n = 0; n < 2; ++n) _Pragma("unroll") for (int k = 0; k < 2; ++k) dst[n][k] = *(const PG8_LAS bf16x8*)(lds + PG8_SB(b, h) + boff + n * 2048 + k * 1024); } while (0)
#define PG8_MMA(ai, bj, At, Bt) do { __builtin_amdgcn_s_setprio(1); _Pragma("unroll") for (int m = 0; m < 4; ++m) _Pragma("unroll") for (int n = 0; n < 2; ++n) _Pragma("unroll") for (int k = 0; k < 2; ++k) \
        acc[ai][bj][m][n] = __builtin_amdgcn_mfma_f32_16x16x32_bf16(Bt[n][k], At[m][k], acc[ai][bj][m][n], 0, 0, 0); __builtin_amdgcn_s_setprio(0); } while (0)
#define PG8_WAIT_V(n) asm volatile("s_waitcnt vmcnt(" #n ")" ::: "memory")
#define PG8_WAIT_L(n) asm volatile("s_waitcnt lgkmcnt(" #n ")" ::: "memory")
#define PG8_BAR __builtin_amdgcn_s_barrier()
#define PG8_SCHED __builtin_amdgcn_sched_barrier(0)
    Unit cur, nxt; int ui = 0;
    if (!S.next(0, cur)) return;
    f32x4 acc[2][2][4][2];
#pragma unroll
    for (int a = 0; a < 2; ++a)
#pragma unroll
        for (int b = 0; b < 2; ++b)
#pragma unroll
            for (int m = 0; m < 4; ++m)
#pragma unroll
                for (int n = 0; n < 2; ++n) acc[a][b][m][n] = (f32x4){0.f, 0.f, 0.f, 0.f};
    bf16x8 At[4][2], B0[2][2], B1[2][2];
    const char* cA = (const char*)g.A + (size_t)cur.pm * tstep; const char* cB = (const char*)g.Bt + (size_t)cur.pn * tstep;
    S.a_ready(cur);
    if constexpr (SP2) {
        PG8_STAGE(PG8_SB(0, 0), cB, voffB); PG8_STAGE(PG8_SB(0, 1), cB + hstep, voffB); PG8_STAGE(PG8_SA(0, 0), cA, voffA); PG8_STAGE(PG8_SA(0, 1), cA + hstep, voffA);
        if (wr == 1) PG8_BAR;
        PG8_WAIT_V(2); PG8_BAR;
        PG8_STAGE(PG8_SB(1, 0), cB + kstep, voffB); PG8_STAGE(PG8_SA(1, 0), cA + kstep, voffA); PG8_STAGE(PG8_SB(1, 1), cB + hstep + kstep, voffB);
        PG8_WAIT_V(6); PG8_BAR;
    } else {
        PG8_STAGE(PG8_SB(0, 0), cB, voffB); PG8_STAGE(PG8_SA(0, 0), cA, voffA); PG8_STAGE(PG8_SB(0, 1), cB + hstep, voffB); PG8_STAGE(PG8_SA(0, 1), cA + hstep, voffA);
        if (wr == 1) PG8_BAR;
        PG8_WAIT_V(4); PG8_BAR;
        PG8_STAGE(PG8_SB(1, 0), cB + kstep, voffB); PG8_STAGE(PG8_SA(1, 0), cA + kstep, voffA); PG8_STAGE(PG8_SB(1, 1), cB + hstep + kstep, voffB);
        PG8_WAIT_V(6); PG8_BAR;
    }
    for (;;) {
        const bool has_next = S.next(ui + 1, nxt);
        const char* nA = has_next ? (const char*)g.A + (size_t)nxt.pm * tstep : cA; const char* nB = has_next ? (const char*)g.Bt + (size_t)nxt.pn * tstep : cB;
        for (int t = 0; t < nt; t += 2) {
            const bool last = (t == nt - 2);
            const char* a1 = cA + (size_t)(t + 1) * kstep;
            const char* a2 = last ? nA : cA + (size_t)(t + 2) * kstep; const char* b2 = last ? nB : cB + (size_t)(t + 2) * kstep;
            const char* a3 = a2 + kstep; const char* b3 = b2 + kstep;
            if (last && has_next) S.a_ready(nxt);
            if constexpr (Epi::SSPRE) { if (last && wid < 4) __builtin_amdgcn_global_load_lds((const unsigned*)(E.SS + cur.pm * BM + wid * 64 + lane), (PG8_LAS unsigned*)(lds + SSLDS_OFF + wid * 256), 4, 0, 0); }
            if constexpr (SP2) {
            PG8_LDB(B0, 0, 0); PG8_LDB(B1, 0, 1); PG8_SCHED; PG8_LDA(At, 0, 0); PG8_STAGE(PG8_SA(1, 1), a1 + hstep, voffA);
            PG8_WAIT_V(8); PG8_WAIT_L(0); PG8_BAR; PG8_MMA(0, 0, At, B0); PG8_MMA(0, 1, At, B1); PG8_BAR; PG8_SCHED;
            PG8_LDA(At, 0, 1); PG8_STAGE(PG8_SB(0, 0), b2, voffB); PG8_STAGE(PG8_SB(0, 1), b2 + hstep, voffB); PG8_STAGE(PG8_SA(0, 0), a2, voffA);
            PG8_WAIT_V(8); PG8_WAIT_L(0); PG8_BAR; PG8_MMA(1, 0, At, B0); PG8_MMA(1, 1, At, B1); PG8_BAR; PG8_SCHED;
            PG8_LDB(B0, 1, 0); PG8_LDB(B1, 1, 1); PG8_SCHED; PG8_LDA(At, 1, 0); PG8_STAGE(PG8_SA(0, 1), a2 + hstep, voffA);
            PG8_WAIT_V(8); PG8_WAIT_L(0); PG8_BAR; PG8_MMA(0, 0, At, B0); PG8_MMA(0, 1, At, B1); PG8_BAR; PG8_SCHED;
            PG8_LDA(At, 1, 1); PG8_STAGE(PG8_SB(1, 0), b3, voffB); PG8_STAGE(PG8_SB(1, 1), b3 + hstep, voffB); PG8_STAGE(PG8_SA(1, 0), a3, voffA);
            PG8_WAIT_V(8); PG8_WAIT_L(0); PG8_BAR; PG8_MMA(1, 0, At, B0); PG8_MMA(1, 1, At, B1); PG8_BAR; PG8_SCHED;
            } else {
            PG8_LDB(B0, 0, 0); PG8_SCHED; PG8_LDA(At, 0, 0); PG8_STAGE(PG8_SA(1, 1), a1 + hstep, voffA);
            PG8_WAIT_L(8); PG8_BAR; PG8_WAIT_L(0); PG8_MMA(0, 0, At, B0); PG8_BAR; PG8_SCHED;
            PG8_LDB(B1, 0, 1); PG8_STAGE(PG8_SB(0, 0), b2, voffB);
            PG8_BAR; PG8_WAIT_L(0); PG8_MMA(0, 1, At, B1); PG8_BAR;
            PG8_LDA(At, 0, 1); PG8_STAGE(PG8_SA(0, 0), a2, voffA);
            PG8_BAR; PG8_WAIT_L(0); PG8_MMA(1, 0, At, B0); PG8_BAR; PG8_SCHED;
            PG8_STAGE(PG8_SB(0, 1), b2 + hstep, voffB);
            PG8_WAIT_V(6); PG8_BAR; PG8_MMA(1, 1, At, B1); PG8_BAR;
            PG8_LDB(B0, 1, 0); PG8_SCHED; PG8_LDA(At, 1, 0); PG8_STAGE(PG8_SA(0, 1), a2 + hstep, voffA);
            PG8_WAIT_L(8); PG8_BAR; PG8_WAIT_L(0); PG8_MMA(0, 0, At, B0); PG8_BAR; PG8_SCHED;
            PG8_LDB(B1, 1, 1); PG8_STAGE(PG8_SB(1, 0), b3, voffB);
            PG8_BAR; PG8_WAIT_L(0); PG8_MMA(0, 1, At, B1); PG8_BAR;
            PG8_LDA(At, 1, 1); PG8_STAGE(PG8_SA(1, 0), a3, voffA);
            PG8_BAR; PG8_WAIT_L(0); PG8_MMA(1, 0, At, B0); PG8_BAR; PG8_SCHED;
            PG8_STAGE(PG8_SB(1, 1), b3 + hstep, voffB);
            PG8_WAIT_V(6); PG8_BAR; PG8_MMA(1, 1, At, B1); PG8_BAR;
            }
        }
        if constexpr (ALIGN_EPI) { if (wr == 0) PG8_BAR; }
        if constexpr (!Epi::AFTER_DRAIN) { E(acc, cur, wr, wc, fr, fq); S.done(cur); }
        if (!has_next) break;
#pragma unroll
        for (int a = 0; a < 2; ++a)
#pragma unroll
            for (int b = 0; b < 2; ++b)
#pragma unroll
                for (int m = 0; m < 4; ++m)
#pragma unroll
                    for (int n = 0; n < 2; ++n) acc[a][b][m][n] = (f32x4){0.f, 0.f, 0.f, 0.f};
        cur = nxt; cA = nA; cB = nB; ++ui;
        if constexpr (ALIGN_EPI) { if (wr == 1) PG8_BAR; }
    }
    PG8_WAIT_V(0);
    if constexpr (!ALIGN_EPI) { if (wr == 0) PG8_BAR; }
    PG8_BAR;
    if constexpr (Epi::AFTER_DRAIN) { E.fused(acc, cur, wr, wc, fr, fq, lds, wid, lane); S.done(cur); }
#undef PG8_SA
#undef PG8_SB
#undef PG8_STAGE
#undef PG8_LDA
#undef PG8_LDB
#undef PG8_MMA
#undef PG8_WAIT_V
#undef PG8_WAIT_L
#undef PG8_BAR
#undef PG8_SCHED
}
}
#define GAS __attribute__((address_space(1)))
#define LAS __attribute__((address_space(3)))
typedef unsigned short bf16;
typedef unsigned v4u __attribute__((ext_vector_type(4)));
typedef unsigned v2u __attribute__((ext_vector_type(2)));
typedef float f32x4 __attribute__((ext_vector_type(4)));
typedef float f32x2 __attribute__((ext_vector_type(2)));
typedef float f32x16 __attribute__((ext_vector_type(16)));
typedef short bf16x8 __attribute__((ext_vector_type(8)));
using pg8::pk_bf16; using pg8::bf_lo; using pg8::bf_hi; using pg8::sigmoid_fast;

constexpr int NWAVES = 8, NTHREADS = NWAVES * 64;
constexpr int BATCH = 4, SEQ = 4096, D = 2048, FF = 5632, M = BATCH * SEQ;
constexpr int S5G = 128, S5H = 16, S5P = 64, CHUNK = 64, NCH = SEQ / CHUNK;
constexpr int NH = 16, HD = 128, NQKV = 3 * D;
constexpr float EPS = 1e-6f;
constexpr size_t MiB = 1u << 20;
constexpr size_t WS_WGU = 0, WGU_BYTES = 44 * MiB, WD_BYTES = 22 * MiB, FFN_SET_BYTES = 66 * MiB;
constexpr size_t WS_WIN = 264 * MiB, WS_WGLU = 272 * MiB, WS_WOUT = 280 * MiB, WS_WQKV = 288 * MiB, WS_WO = 312 * MiB;
constexpr size_t WS_H = 320 * MiB;
constexpr size_t WS_BIG = 384 * MiB;
constexpr size_t WS_T1 = 576 * MiB;
constexpr size_t WS_T2 = 640 * MiB;
constexpr size_t WS_E = 704 * MiB;
constexpr size_t WS_BAR = 720 * MiB;
constexpr size_t WS_SS = 721 * MiB;
constexpr size_t WS_END = 722 * MiB;
constexpr int LDS_BYTES = 147456;
constexpr int LDS_MISC = 147456 - 256;

struct Params { const float* in[26]; float* out; unsigned char* ws; int ph_lo, ph_hi; };
enum { I_X = 0, I_NF1, I_F1G, I_F1U, I_F1D, I_NMIX, I_WIN, I_LRE, I_LIM, I_LDT, I_BRE, I_BIM, I_CRE, I_CIM, I_DSK, I_WGLU, I_BGLU, I_WOUT, I_WQKV, I_GQ, I_GK, I_WO, I_NF2, I_F2G, I_F2U, I_F2D };

#define LDS_WAIT() asm volatile("s_waitcnt lgkmcnt(0)" ::: "memory")

__device__ __forceinline__ void cvt_item(const float* W, int K, int N, bf16* WT, int mode, LAS float* scr, int item, int lane, const float* gain = nullptr) {
    const int nblk = N / 32, kb = item / nblk, nb = item % nblk, k0 = 64 * kb, n0 = 32 * nb;
    const int r0 = (mode == 0) ? n0 : ((n0 >> 7) * 256 + (mode == 2 ? 128 : 0) + (n0 & 127));
#pragma unroll 8
    for (int i = 0; i < 32; ++i) { const int kk = 2 * i + (lane >> 5); scr[kk * 33 + (lane & 31)] = W[(size_t)(k0 + kk) * N + n0 + (lane & 31)]; }
    LDS_WAIT();
    const int c = lane & 7;
    f32x4 ga = {1.f, 1.f, 1.f, 1.f}, gb = ga; if (gain) { ga = *(const f32x4*)(gain + k0 + 8 * c); gb = *(const f32x4*)(gain + k0 + 8 * c + 4); }
#pragma unroll
    for (int j = 0; j < 4; ++j) { const int n = (lane >> 3) + 8 * j; const LAS float* s = scr + (8 * c) * 33 + n;
        v4u o; o.x = pk_bf16(s[0 * 33] * ga.x, s[1 * 33] * ga.y); o.y = pk_bf16(s[2 * 33] * ga.z, s[3 * 33] * ga.w); o.z = pk_bf16(s[4 * 33] * gb.x, s[5 * 33] * gb.y); o.w = pk_bf16(s[6 * 33] * gb.z, s[7 * 33] * gb.w);
        *(v4u*)(WT + (size_t)(r0 + n) * K + k0 + 8 * c) = o; }
    LDS_WAIT();
}
__device__ __forceinline__ float wave_sum(float v) {
#pragma unroll
    for (int o = 1; o < 64; o <<= 1) v += __shfl_xor(v, o);
    return v;
}
__device__ __forceinline__ void norm_row(const float* xrow, const float* gain, bf16* orow, int lane) {
    const f32x4* xr = (const f32x4*)xrow + lane; const f32x4* gr = (const f32x4*)gain + lane;
    f32x4 v[8]; float s = 0.f;
#pragma unroll
    for (int j = 0; j < 8; ++j) { v[j] = xr[64 * j]; s += (v[j].x * v[j].x + v[j].y * v[j].y) + (v[j].z * v[j].z + v[j].w * v[j].w); }
    const float rstd = 1.0f / sqrtf(wave_sum(s) * (1.f / D) + EPS);
    v2u* o8 = (v2u*)orow + lane;
#pragma unroll
    for (int j = 0; j < 8; ++j) { const f32x4 g = gr[64 * j]; v2u w; w.x = pk_bf16(v[j].x * rstd * g.x, v[j].y * rstd * g.y); w.y = pk_bf16(v[j].z * rstd * g.z, v[j].w * rstd * g.w); o8[64 * j] = w; }
}
__device__ __forceinline__ void norm_phase(const float* X, const float* gain, bf16* H, int gw, int NGW, int lane) {
    for (int m = gw; m < M; m += NGW) norm_row(X + (size_t)m * D, gain, H + (size_t)m * D, lane);
}
__device__ __forceinline__ void p0_phase(const Params& P, LAS unsigned char* lds, int gw, int NGW, int wave, int lane) {
    LAS float* scr = (LAS float*)(lds + wave * 16384);
    constexpr int I_G = (D / 64) * (FF / 32), I_DN = (FF / 64) * (D / 32), I_SET = 2 * I_G + I_DN;
    constexpr int I_SQ = (D / 64) * (D / 32), I_QKV = (D / 64) * (NQKV / 32);
    constexpr int NITEMS = 4 * I_SET + 4 * I_SQ + I_QKV;
    unsigned char* ws = P.ws;
    for (int it = gw; it < NITEMS; it += NGW) {
        int r = it;
        if (r < 4 * I_SET) { const int set = r / I_SET; r -= set * I_SET; const int layer = set >> 1, second = set & 1;
            bf16* wgu = (bf16*)(ws + WS_WGU + (size_t)set * FFN_SET_BYTES); bf16* wd = (bf16*)(ws + WS_WGU + (size_t)set * FFN_SET_BYTES + WGU_BYTES);
            const float* g = P.in[second ? I_F2G : I_F1G] + (size_t)layer * D * FF; const float* u = P.in[second ? I_F2U : I_F1U] + (size_t)layer * D * FF; const float* dn = P.in[second ? I_F2D : I_F1D] + (size_t)layer * FF * D;
            const float* gn = P.in[second ? I_NF2 : I_NF1] + layer * D;
            if (r < I_G) { cvt_item(g, D, FF, wgu, 1, scr, r, lane, gn); continue; } r -= I_G;
            if (r < I_G) { cvt_item(u, D, FF, wgu, 2, scr, r, lane, gn); continue; } r -= I_G;
            cvt_item(dn, FF, D, wd, 0, scr, r, lane); continue; }
        r -= 4 * I_SET;
        if (r < I_SQ) { cvt_item(P.in[I_WIN], D, D, (bf16*)(ws + WS_WIN), 0, scr, r, lane, P.in[I_NMIX]); continue; } r -= I_SQ;
        if (r < I_SQ) { cvt_item(P.in[I_WGLU], D, D, (bf16*)(ws + WS_WGLU), 0, scr, r, lane); continue; } r -= I_SQ;
        if (r < I_SQ) { cvt_item(P.in[I_WOUT], D, D, (bf16*)(ws + WS_WOUT), 0, scr, r, lane); continue; } r -= I_SQ;
        if (r < I_SQ) { cvt_item(P.in[I_WO], D, D, (bf16*)(ws + WS_WO), 0, scr, r, lane); continue; } r -= I_SQ;
        cvt_item(P.in[I_WQKV], D, NQKV, (bf16*)(ws + WS_WQKV), 0, scr, r, lane, P.in[I_NMIX] + D);
    }
    float* SS = (float*)(ws + WS_SS);
    for (int i = gw * 64 + lane; i < 6 * M; i += NGW * 64) SS[M + i] = 0.f;
    for (int m = gw; m < M; m += NGW) {
        const f32x4* xr = (const f32x4*)(P.in[I_X] + (size_t)m * D) + lane; v2u* o8 = (v2u*)((bf16*)(ws + WS_H) + (size_t)m * D) + lane; float s = 0.f;
#pragma unroll
        for (int j = 0; j < 8; ++j) { const f32x4 v = xr[64 * j]; s += (v.x * v.x + v.y * v.y) + (v.z * v.z + v.w * v.w); v2u w; w.x = pk_bf16(v.x, v.y); w.y = pk_bf16(v.z, v.w); o8[64 * j] = w; }
        s = wave_sum(s); if (lane == 0) ((unsigned*)SS)[m] = (unsigned)(s * 4096.0f + 0.5f); }
}

__device__ __forceinline__ void sincos_acc(float x, float& s, float& c) {
    const float jf = rintf(x * 0.636619772f); const int j = (int)jf;
    float y = fmaf(-jf, 1.5703125f, x); y = fmaf(-jf, 4.837512969970703125e-4f, y); y = fmaf(-jf, 7.54978995489188216e-8f, y);
    const float z = y * y;
    const float sp = fmaf(fmaf(fmaf(-1.9515295891e-4f, z, 8.3321608736e-3f), z, -1.6666654611e-1f) * z, y, y);
    const float cp = fmaf(fmaf(fmaf(2.443315711809948e-5f, z, -1.388731625493765e-3f), z, 4.166664568298827e-2f), z * z, fmaf(-0.5f, z, 1.0f));
    const int q = j & 3;
    const float ss = (q & 1) ? cp : sp, cc = (q & 1) ? sp : cp;
    s = (q & 2) ? -ss : ss; c = ((q + 1) & 2) ? -cc : cc;
}
__device__ __forceinline__ void s5_setup(const Params& P, int g, int p, float& are, float& aim, f32x2 (&bb)[16]) {
    const float dt = expf(P.in[I_LDT][g]);
    const float lr = fminf(P.in[I_LRE][g * S5P + p], -1e-4f), li = P.in[I_LIM][g * S5P + p];
    const float mag = expf(lr * dt); float sn, cs; sincos_acc(li * dt, sn, cs);
    are = mag * cs; aim = mag * sn;
    const float den = lr * lr + li * li, nre = are - 1.0f;
    const float fre = (nre * lr + aim * li) / den, fim = (aim * lr - nre * li) / den;
    const f32x4* br = (const f32x4*)(P.in[I_BRE] + (size_t)(g * S5P + p) * S5H); const f32x4* bi = (const f32x4*)(P.in[I_BIM] + (size_t)(g * S5P + p) * S5H);
#pragma unroll
    for (int q = 0; q < 4; ++q) { const f32x4 r4 = br[q], i4 = bi[q];
#pragma unroll
        for (int e = 0; e < 4; ++e) { bb[4 * q + e].x = fre * r4[e] - fim * i4[e]; bb[4 * q + e].y = fre * i4[e] + fim * r4[e]; } }
}
__device__ __forceinline__ void s5_load_u(const float* U, int row0, int g, int lane, f32x4 (&pre)[4]) {
    const f32x4* src = (const f32x4*)(U + (size_t)(row0 + lane) * D + g * S5H);
    pre[0] = src[0]; pre[1] = src[1]; pre[2] = src[2]; pre[3] = src[3];
}
__device__ __forceinline__ void s5_put_u(LAS float* ubuf, int lane, const f32x4 (&pre)[4]) {
    LAS f32x4* dst = (LAS f32x4*)(ubuf + lane * 16);
    dst[0] = pre[0]; dst[1] = pre[1]; dst[2] = pre[2]; dst[3] = pre[3];
    LDS_WAIT();
}
__device__ __forceinline__ void s5_step(const LAS float* urow, const f32x2 (&bb)[16], float are, float aim, float& sre, float& sim) {
    const LAS f32x4* u4 = (const LAS f32x4*)urow;
    f32x2 bu = {0.f, 0.f};
#pragma unroll
    for (int q = 0; q < 4; ++q) { const f32x4 uu = u4[q];
#pragma unroll
        for (int e = 0; e < 4; ++e) { const f32x2 ub = {uu[e], uu[e]}; bu += bb[4 * q + e] * ub; } }
    const float nre = fmaf(are, sre, fmaf(-aim, sim, bu.x)), nim = fmaf(are, sim, fmaf(aim, sre, bu.y));
    sre = nre; sim = nim;
}
template <bool STORE>
__device__ __forceinline__ void s5_step4(const LAS float* urow, const f32x2 (&bb)[16], float are, float aim, float& sre, float& sim, LAS unsigned char* sw) {
    f32x4 uu[4][4];
#pragma unroll
    for (int s = 0; s < 4; ++s)
#pragma unroll
        for (int q = 0; q < 4; ++q) uu[s][q] = ((const LAS f32x4*)(urow + s * 16))[q];
    f32x2 acc[4][2];
#pragma unroll
    for (int s = 0; s < 4; ++s) { acc[s][0] = (f32x2){0.f, 0.f}; acc[s][1] = (f32x2){0.f, 0.f}; }
#pragma unroll
    for (int q = 0; q < 4; ++q)
#pragma unroll
        for (int e = 0; e < 4; ++e)
#pragma unroll
            for (int s = 0; s < 4; ++s) { const float uv = uu[s][q][e]; const f32x2 ub = {uv, uv}; acc[s][e & 1] += bb[4 * q + e] * ub; }
#pragma unroll
    for (int s = 0; s < 4; ++s) { const f32x2 bu = acc[s][0] + acc[s][1];
        const float nre = fmaf(are, sre, fmaf(-aim, sim, bu.x)), nim = fmaf(are, sim, fmaf(aim, sre, bu.y)); sre = nre; sim = nim;
        if (STORE) *(LAS unsigned*)(sw + s * 272) = pk_bf16(sre, sim); }
}
constexpr int NQ = 4, QLEN = SEQ / NQ, CPQ = QLEN / CHUNK;
__device__ __forceinline__ void s5_pass_a(const Params& P, LAS unsigned char* lds, int gw, int NGW, int wave, int lane) {
    LAS float* ubuf = (LAS float*)(lds + wave * 16384);
    const float* U = (const float*)(P.ws + WS_BIG); f32x2* E = (f32x2*)(P.ws + WS_E);
    for (int task = gw; task < BATCH * S5G * (NQ - 1); task += NGW) {
        const int g = task % S5G, b = (task / S5G) % BATCH, q = task / (S5G * BATCH);
        float are, aim; f32x2 bb[16]; s5_setup(P, g, lane, are, aim, bb);
        float sre = 0.f, sim = 0.f;
        f32x4 pre[4]; s5_load_u(U, b * SEQ + q * QLEN, g, lane, pre);
#pragma unroll 1
        for (int c = 0; c < CPQ; ++c) {
            s5_put_u(ubuf, lane, pre);
            s5_load_u(U, b * SEQ + q * QLEN + (c + 1 < CPQ ? c + 1 : c) * CHUNK, g, lane, pre);
#pragma unroll 2
            for (int t = 0; t < CHUNK; t += 4) s5_step4<false>(ubuf + t * 16, bb, are, aim, sre, sim, nullptr);
            LDS_WAIT();
        }
        E[((size_t)(b * NQ + q) * S5G + g) * S5P + lane] = (f32x2){sre, sim};
    }
}
__device__ __forceinline__ float gelu_tanh(float y) { const float z = 0.7978845608028654f * (y + 0.044715f * y * y * y); return y * sigmoid_fast(2.0f * z); }
__device__ __forceinline__ void s5_pass_b(const Params& P, LAS unsigned char* lds, int gw, int NGW, int wave, int lane) {
    LAS float* ubuf = (LAS float*)(lds + wave * 16384);
    LAS unsigned char* sbuf = lds + wave * 16384 + 4096;
    const float* U = (const float*)(P.ws + WS_BIG); const f32x2* E = (const f32x2*)(P.ws + WS_E); bf16* Y = (bf16*)(P.ws + WS_T1);
    const int fr = lane & 15, fq = lane >> 4;
    for (int task = gw; task < BATCH * S5G * NQ; task += NGW) {
        const int g = task % S5G, b = (task / S5G) % BATCH, q = task / (S5G * BATCH);
        float are, aim; f32x2 bb[16]; s5_setup(P, g, lane, are, aim, bb);
        float aqr = are, aqi = aim;
#pragma unroll
        for (int i = 0; i < 10; ++i) { const float nr = aqr * aqr - aqi * aqi, ni = 2.0f * aqr * aqi; aqr = nr; aqi = ni; }
        float sre = 0.f, sim = 0.f;
        for (int q2 = 0; q2 < q; ++q2) { const f32x2 e = E[((size_t)(b * NQ + q2) * S5G + g) * S5P + lane];
            const float nr = fmaf(aqr, sre, fmaf(-aqi, sim, e.x)), ni = fmaf(aqr, sim, fmaf(aqi, sre, e.y)); sre = nr; sim = ni; }
        bf16x8 ac[4];
#pragma unroll
        for (int ks = 0; ks < 4; ++ks) { const f32x4 cr = *(const f32x4*)(P.in[I_CRE] + (size_t)(g * S5H + fr) * S5P + 16 * ks + 4 * fq), ci = *(const f32x4*)(P.in[I_CIM] + (size_t)(g * S5H + fr) * S5P + 16 * ks + 4 * fq);
            v4u w; w.x = pk_bf16(cr.x, -ci.x); w.y = pk_bf16(cr.y, -ci.y); w.z = pk_bf16(cr.z, -ci.z); w.w = pk_bf16(cr.w, -ci.w); ac[ks] = __builtin_bit_cast(bf16x8, w); }
        const f32x4 dsk = *(const f32x4*)(P.in[I_DSK] + g * S5H + 4 * fq);
        f32x4 pre[4]; s5_load_u(U, b * SEQ + q * QLEN, g, lane, pre);
#pragma unroll 1
        for (int c = 0; c < CPQ; ++c) {
            const int row0 = b * SEQ + q * QLEN + c * CHUNK;
            s5_put_u(ubuf, lane, pre);
            s5_load_u(U, b * SEQ + q * QLEN + (c + 1 < CPQ ? c + 1 : c) * CHUNK, g, lane, pre);
#pragma unroll 1
            for (int half = 0; half < 2; ++half) {
#pragma unroll 2
                for (int tt = 0; tt < 32; tt += 4) s5_step4<true>(ubuf + (half * 32 + tt) * 16, bb, are, aim, sre, sim, sbuf + tt * 272 + 4 * lane);
                LDS_WAIT();
#pragma unroll
                for (int tile = 0; tile < 2; ++tile) { f32x4 acc = {0.f, 0.f, 0.f, 0.f};
#pragma unroll
                    for (int ks = 0; ks < 4; ++ks) { const bf16x8 sb = *(const LAS bf16x8*)(sbuf + (tile * 16 + fr) * 272 + 64 * ks + 16 * fq);
                        acc = __builtin_amdgcn_mfma_f32_16x16x32_bf16(ac[ks], sb, acc, 0, 0, 0); }
                    const int t = half * 32 + tile * 16 + fr;
                    const f32x4 uu = *(const LAS f32x4*)(ubuf + t * 16 + 4 * fq);
                    v2u w; w.x = pk_bf16(gelu_tanh(acc[0] + dsk[0] * uu[0]), gelu_tanh(acc[1] + dsk[1] * uu[1])); w.y = pk_bf16(gelu_tanh(acc[2] + dsk[2] * uu[2]), gelu_tanh(acc[3] + dsk[3] * uu[3]));
                    *(v2u*)(Y + (size_t)(row0 + t) * D + g * S5H + 4 * fq) = w; }
                LDS_WAIT();
            }
        }
    }
}


constexpr int S5W = 17920, S5_UB = 0, S5_BU = 2048, S5_PLANE = 64 * 80, S5_SB = S5_BU + 2 * S5_PLANE;
static_assert(S5_SB + 16 * 272 <= S5W, "S5 LDS map");
__device__ __forceinline__ void s5_disc(const Params& P, int g, int p, float& are, float& aim, float& fre, float& fim) {
    const float dt = expf(P.in[I_LDT][g]);
    const float lr = fminf(P.in[I_LRE][g * S5P + p], -1e-4f), li = P.in[I_LIM][g * S5P + p];
    const float mag = expf(lr * dt); float sn, cs; sincos_acc(li * dt, sn, cs);
    are = mag * cs; aim = mag * sn;
    const float den = lr * lr + li * li, nre = are - 1.0f;
    fre = (nre * lr + aim * li) / den; fim = (aim * lr - nre * li) / den;
}
__device__ __forceinline__ void s5_bops(const Params& P, int g, int fr, int fq, bf16x8 (&bop)[8]) {
    const int hq = fq & 1; const bool live = fq < 2;
#pragma unroll
    for (int pb = 0; pb < 4; ++pb) { const int p = 16 * pb + fr;
        float are, aim, fre, fim; s5_disc(P, g, p, are, aim, fre, fim);
        const f32x4* br = (const f32x4*)(P.in[I_BRE] + (size_t)(g * S5P + p) * S5H + 8 * hq); const f32x4* bi = (const f32x4*)(P.in[I_BIM] + (size_t)(g * S5P + p) * S5H + 8 * hq);
        const f32x4 r0 = br[0], r1 = br[1], i0 = bi[0], i1 = bi[1];
        float re[8], im[8];
#pragma unroll
        for (int e = 0; e < 4; ++e) { re[e] = fre * r0[e] - fim * i0[e]; im[e] = fre * i0[e] + fim * r0[e]; re[4 + e] = fre * r1[e] - fim * i1[e]; im[4 + e] = fre * i1[e] + fim * r1[e]; }
        v4u wr, wi; wr.x = pk_bf16(re[0], re[1]); wr.y = pk_bf16(re[2], re[3]); wr.z = pk_bf16(re[4], re[5]); wr.w = pk_bf16(re[6], re[7]);
        wi.x = pk_bf16(im[0], im[1]); wi.y = pk_bf16(im[2], im[3]); wi.z = pk_bf16(im[4], im[5]); wi.w = pk_bf16(im[6], im[7]);
        if (!live) { wr = (v4u){0u, 0u, 0u, 0u}; wi = wr; }
        bop[2 * pb] = __builtin_bit_cast(bf16x8, wr); bop[2 * pb + 1] = __builtin_bit_cast(bf16x8, wi); }
}
__device__ __forceinline__ void s5_load_ub(const bf16* U, int row0, int g, int lane, v4u (&pre)[2]) {
    const v4u* src = (const v4u*)(U + (size_t)(row0 + lane) * D + g * S5H); pre[0] = src[0]; pre[1] = src[1];
}
__device__ __forceinline__ void s5_put_ub(LAS unsigned char* ub, int lane, const v4u (&pre)[2]) {
    *(LAS v4u*)(ub + lane * 32) = pre[0]; *(LAS v4u*)(ub + lane * 32 + 16) = pre[1];
    LDS_WAIT();
}
__device__ __forceinline__ void s5_put_u_bf16(LAS unsigned char* ub, int lane, const f32x4 (&pre)[4]) {
    v4u a, b; a.x = pk_bf16(pre[0].x, pre[0].y); a.y = pk_bf16(pre[0].z, pre[0].w); a.z = pk_bf16(pre[1].x, pre[1].y); a.w = pk_bf16(pre[1].z, pre[1].w);
    b.x = pk_bf16(pre[2].x, pre[2].y); b.y = pk_bf16(pre[2].z, pre[2].w); b.z = pk_bf16(pre[3].x, pre[3].y); b.w = pk_bf16(pre[3].z, pre[3].w);
    *(LAS v4u*)(ub + lane * 32) = a; *(LAS v4u*)(ub + lane * 32 + 16) = b;
    LDS_WAIT();
}
__device__ __forceinline__ void s5_bu16(LAS unsigned char* wl, int t0, int fr, int fq, const bf16x8 (&bop)[8]) {
    v4u araw = *(const LAS v4u*)(wl + S5_UB + (t0 + fr) * 32 + 16 * (fq & 1)); if (fq >= 2) araw = (v4u){0u, 0u, 0u, 0u};
    const bf16x8 af = __builtin_bit_cast(bf16x8, araw);
    f32x4 acc[8];
#pragma unroll
    for (int nt = 0; nt < 8; ++nt) { acc[nt] = (f32x4){0.f, 0.f, 0.f, 0.f};
        acc[nt] = __builtin_amdgcn_mfma_f32_16x16x32_bf16(af, bop[nt], acc[nt], 0, 0, 0); }
    asm volatile("s_nop 15\n\ts_nop 15" : "+v"(acc[0]), "+v"(acc[1]), "+v"(acc[2]), "+v"(acc[3]), "+v"(acc[4]), "+v"(acc[5]), "+v"(acc[6]), "+v"(acc[7]) :: "memory");
#pragma unroll
    for (int nt = 0; nt < 8; ++nt) *(LAS f32x4*)(wl + S5_BU + (nt & 1) * S5_PLANE + (16 * (nt >> 1) + fr) * 80 + 16 * fq) = acc[nt];
    asm volatile("" :: "v"(af));
    LDS_WAIT();
}
template <bool STORE>
__device__ __forceinline__ void s5_scan16(LAS unsigned char* wl, int lane, float are, float aim, float& sre, float& sim) {
    f32x4 re4[4], im4[4];
#pragma unroll
    for (int q = 0; q < 4; ++q) { re4[q] = *(const LAS f32x4*)(wl + S5_BU + lane * 80 + 16 * q); im4[q] = *(const LAS f32x4*)(wl + S5_BU + S5_PLANE + lane * 80 + 16 * q); }
#pragma unroll
    for (int q = 0; q < 4; ++q)
#pragma unroll
        for (int e = 0; e < 4; ++e) { const float nre = fmaf(are, sre, fmaf(-aim, sim, re4[q][e])), nim = fmaf(are, sim, fmaf(aim, sre, im4[q][e])); sre = nre; sim = nim;
            if (STORE) *(LAS unsigned*)(wl + S5_SB + (4 * q + e) * 272 + 4 * lane) = pk_bf16(sre, sim); }
    LDS_WAIT();
}
__device__ __forceinline__ void s5_pass_a2(const Params& P, LAS unsigned char* lds, int gw, int NGW, int wave, int lane) {
    LAS unsigned char* wl = lds + wave * S5W;
    const bf16* U = (const bf16*)(P.ws + WS_BIG); f32x2* E = (f32x2*)(P.ws + WS_E);
    const int fr = lane & 15, fq = lane >> 4;
    for (int task = gw; task < BATCH * S5G * (NQ - 1); task += NGW) {
        const int g = task % S5G, b = (task / S5G) % BATCH, q = task / (S5G * BATCH);
        float are, aim, fre, fim; s5_disc(P, g, lane, are, aim, fre, fim);
        bf16x8 bop[8]; s5_bops(P, g, fr, fq, bop);
        float sre = 0.f, sim = 0.f;
        v4u pre[2]; s5_load_ub(U, b * SEQ + q * QLEN, g, lane, pre);
#pragma unroll 1
        for (int c = 0; c < CPQ; ++c) {
            s5_put_ub(wl + S5_UB, lane, pre);
            s5_load_ub(U, b * SEQ + q * QLEN + (c + 1 < CPQ ? c + 1 : c) * CHUNK, g, lane, pre);
#pragma unroll 1
            for (int blk = 0; blk < 4; ++blk) { s5_bu16(wl, 16 * blk, fr, fq, bop); s5_scan16<false>(wl, lane, are, aim, sre, sim); }
        }
        E[((size_t)(b * NQ + q) * S5G + g) * S5P + lane] = (f32x2){sre, sim};
    }
}
__device__ __forceinline__ void s5_pass_b2(const Params& P, LAS unsigned char* lds, int gw, int NGW, int wave, int lane) {
    LAS unsigned char* wl = lds + wave * S5W;
    const bf16* U = (const bf16*)(P.ws + WS_BIG); const f32x2* E = (const f32x2*)(P.ws + WS_E); bf16* Y = (bf16*)(P.ws + WS_T1);
    const int fr = lane & 15, fq = lane >> 4;
    for (int task = gw; task < BATCH * S5G * NQ; task += NGW) {
        const int g = task % S5G, b = (task / S5G) % BATCH, q = task / (S5G * BATCH);
        float are, aim, fre, fim; s5_disc(P, g, lane, are, aim, fre, fim);
        bf16x8 bop[8]; s5_bops(P, g, fr, fq, bop);
        float aqr = are, aqi = aim;
#pragma unroll
        for (int i = 0; i < 10; ++i) { const float nr = aqr * aqr - aqi * aqi, ni = 2.0f * aqr * aqi; aqr = nr; aqi = ni; }
        float sre = 0.f, sim = 0.f;
        for (int q2 = 0; q2 < q; ++q2) { const f32x2 e = E[((size_t)(b * NQ + q2) * S5G + g) * S5P + lane];
            const float nr = fmaf(aqr, sre, fmaf(-aqi, sim, e.x)), ni = fmaf(aqr, sim, fmaf(aqi, sre, e.y)); sre = nr; sim = ni; }
        bf16x8 ac[4];
#pragma unroll
        for (int ks = 0; ks < 4; ++ks) { const f32x4 cr = *(const f32x4*)(P.in[I_CRE] + (size_t)(g * S5H + fr) * S5P + 16 * ks + 4 * fq), ci = *(const f32x4*)(P.in[I_CIM] + (size_t)(g * S5H + fr) * S5P + 16 * ks + 4 * fq);
            v4u w; w.x = pk_bf16(cr.x, -ci.x); w.y = pk_bf16(cr.y, -ci.y); w.z = pk_bf16(cr.z, -ci.z); w.w = pk_bf16(cr.w, -ci.w); ac[ks] = __builtin_bit_cast(bf16x8, w); }
        const f32x4 dsk = *(const f32x4*)(P.in[I_DSK] + g * S5H + 4 * fq);
        v4u pre[2]; s5_load_ub(U, b * SEQ + q * QLEN, g, lane, pre);
#pragma unroll 1
        for (int c = 0; c < CPQ; ++c) {
            const int row0 = b * SEQ + q * QLEN + c * CHUNK;
            s5_put_ub(wl + S5_UB, lane, pre);
            s5_load_ub(U, b * SEQ + q * QLEN + (c + 1 < CPQ ? c + 1 : c) * CHUNK, g, lane, pre);
#pragma unroll 1
            for (int blk = 0; blk < 4; ++blk) {
                s5_bu16(wl, 16 * blk, fr, fq, bop);
                s5_scan16<true>(wl, lane, are, aim, sre, sim);
                f32x4 acc = {0.f, 0.f, 0.f, 0.f};
#pragma unroll
                for (int ks = 0; ks < 4; ++ks) { const bf16x8 sb = *(const LAS bf16x8*)(wl + S5_SB + fr * 272 + 64 * ks + 16 * fq);
                    acc = __builtin_amdgcn_mfma_f32_16x16x32_bf16(ac[ks], sb, acc, 0, 0, 0); }
                asm volatile("s_nop 15" : "+v"(acc) :: "memory");
                const int t = 16 * blk + fr;
                const v2u ur = *(const LAS v2u*)(wl + S5_UB + t * 32 + 8 * fq);
                const float u0 = bf_lo(ur.x), u1 = bf_hi(ur.x), u2 = bf_lo(ur.y), u3 = bf_hi(ur.y);
                v2u w; w.x = pk_bf16(gelu_tanh(acc[0] + dsk[0] * u0), gelu_tanh(acc[1] + dsk[1] * u1)); w.y = pk_bf16(gelu_tanh(acc[2] + dsk[2] * u2), gelu_tanh(acc[3] + dsk[3] * u3));
                *(v2u*)(Y + (size_t)(row0 + t) * D + g * S5H + 4 * fq) = w;
                LDS_WAIT();
            }
        }
    }
}

__device__ __forceinline__ void sb_prep(const Params& P, LAS unsigned char* lds, int gw, int NGW, int wave, int lane) {
    bf16* QKV = (bf16*)(P.ws + WS_BIG); bf16* Vt = (bf16*)(P.ws + WS_T1);
    for (int task = gw; task < 2 * M; task += NGW) {
        const int m = task >> 1, which = task & 1;
        bf16* ptr = QKV + (size_t)m * NQKV + which * D + (lane >> 2) * HD + (lane & 3) * 32;
        const float* gain = P.in[which ? I_GK : I_GQ] + (lane & 3) * 32;
        v4u raw[4]; float v[32]; float ss = 0.f;
#pragma unroll
        for (int q = 0; q < 4; ++q) raw[q] = ((const v4u*)ptr)[q];
#pragma unroll
        for (int q = 0; q < 4; ++q)
#pragma unroll
            for (int e = 0; e < 4; ++e) { const unsigned w = raw[q][e]; v[8 * q + 2 * e] = bf_lo(w); v[8 * q + 2 * e + 1] = bf_hi(w); }
#pragma unroll
        for (int i = 0; i < 32; ++i) ss += v[i] * v[i];
        ss += __shfl_xor(ss, 1); ss += __shfl_xor(ss, 2);
        float rstd = 1.0f / sqrtf(ss * (1.f / HD) + EPS); if (!which) rstd *= 0.08838834764831845f;
#pragma unroll
        for (int q = 0; q < 4; ++q) { const f32x4 g0 = *(const f32x4*)(gain + 8 * q), g1 = *(const f32x4*)(gain + 8 * q + 4);
            v4u w; w.x = pk_bf16(v[8 * q] * rstd * g0.x, v[8 * q + 1] * rstd * g0.y); w.y = pk_bf16(v[8 * q + 2] * rstd * g0.z, v[8 * q + 3] * rstd * g0.w);
            w.z = pk_bf16(v[8 * q + 4] * rstd * g1.x, v[8 * q + 5] * rstd * g1.y); w.w = pk_bf16(v[8 * q + 6] * rstd * g1.z, v[8 * q + 7] * rstd * g1.w);
            ((v4u*)ptr)[q] = w; }
    }
    LAS unsigned char* tile = lds + wave * 16384;
    for (int task = gw; task < BATCH * NH * (SEQ / 32); task += NGW) {
        const int tb = task % (SEQ / 32), hh = (task / (SEQ / 32)) % NH, b = task / ((SEQ / 32) * NH);
#pragma unroll
        for (int i = 0; i < 8; ++i) { const int id = i * 64 + lane, tok = id >> 4, c = id & 15;
            const v4u x = *(const v4u*)(QKV + (size_t)(b * SEQ + tb * 32 + tok) * NQKV + 2 * D + hh * HD + c * 8);
            *(LAS v4u*)(tile + tok * 272 + c * 16) = x; }
        LDS_WAIT();
#pragma unroll
        for (int i = 0; i < 8; ++i) { const int id = i * 64 + lane, d = id >> 2, c = id & 3;
            unsigned short e[8];
#pragma unroll
            for (int j = 0; j < 8; ++j) e[j] = *(const LAS unsigned short*)(tile + (c * 8 + j) * 272 + d * 2);
            v4u w; w.x = e[0] | ((unsigned)e[1] << 16); w.y = e[2] | ((unsigned)e[3] << 16); w.z = e[4] | ((unsigned)e[5] << 16); w.w = e[6] | ((unsigned)e[7] << 16);
            *(v4u*)(Vt + ((size_t)((b * NH + hh) * HD + d)) * SEQ + tb * 32 + c * 8) = w; }
        LDS_WAIT();
    }
}
#define MFMA32(a, b, c) __builtin_amdgcn_mfma_f32_32x32x16_bf16((a), (b), (c), 0, 0, 0)
constexpr int AT_KSTR = 272, AT_VSTR = 72, AT_KBYTES = 32 * AT_KSTR, AT_WAVE_BYTES = AT_KBYTES + 128 * AT_VSTR;
__device__ __forceinline__ void sb_attn(const Params& P, LAS unsigned char* lds, int gw, int NGW, int wave, int lane) {
    const bf16* QKV = (const bf16*)(P.ws + WS_BIG); const bf16* Vt = (const bf16*)(P.ws + WS_T1); bf16* O = (bf16*)(P.ws + WS_T2);
    const int r = lane & 31, h = lane >> 5;
    LAS unsigned char* kbuf = lds + wave * AT_WAVE_BYTES; LAS unsigned char* vbuf = kbuf + AT_KBYTES;
    const int krow_l = lane >> 4, kc = lane & 15, vrow_l = lane >> 2, vc = lane & 3;
    for (int task = gw; task < BATCH * NH * (SEQ / 32); task += NGW) {
        const int qb = task % (SEQ / 32), hh = (task / (SEQ / 32)) % NH, b = task / ((SEQ / 32) * NH);
        const int q0 = 32 * qb, tq = q0 + r;
        const bf16* qrow = QKV + (size_t)(b * SEQ + q0 + r) * NQKV + hh * HD + 8 * h;
        bf16x8 qf[8];
#pragma unroll
        for (int s = 0; s < 8; ++s) qf[s] = *(const bf16x8*)(qrow + 16 * s);
        f32x16 o[4];
#pragma unroll
        for (int dt = 0; dt < 4; ++dt)
#pragma unroll
            for (int i = 0; i < 16; ++i) o[dt][i] = 0.f;
        float R = 0.f;
        const char* kbase = (const char*)(QKV + (size_t)(b * SEQ) * NQKV + D + hh * HD);
        const char* vbase = (const char*)(Vt + ((size_t)((b * NH + hh) * HD)) * SEQ);
        unsigned koff = (unsigned)(krow_l * NQKV + 8 * kc) * 2u, voff = (unsigned)(vrow_l * SEQ + 8 * vc) * 2u;
        asm volatile("" : "+v"(koff), "+v"(voff));
        v4u kraw[8], vraw[8];
#pragma unroll
        for (int i = 0; i < 8; ++i) { kraw[i] = *(const v4u*)(kbase + (size_t)(32 * qb + 4 * i) * (NQKV * 2) + koff); vraw[i] = *(const v4u*)(vbase + (size_t)(16 * i * SEQ + 32 * qb) * 2 + voff); }
        for (int kt = qb; kt >= 0; --kt) {
            const int k0 = 32 * kt;
#pragma unroll
            for (int i = 0; i < 8; ++i) { *(LAS v4u*)(kbuf + (4 * i + krow_l) * AT_KSTR + 16 * kc) = kraw[i];
                LAS v2u* vd = (LAS v2u*)(vbuf + (16 * i + vrow_l) * AT_VSTR + 16 * vc); vd[0] = (v2u){vraw[i].x, vraw[i].y}; vd[1] = (v2u){vraw[i].z, vraw[i].w}; }
            LDS_WAIT();
            { const int kn = kt > 0 ? kt - 1 : 0;
#pragma unroll
              for (int i = 0; i < 8; ++i) { kraw[i] = *(const v4u*)(kbase + (size_t)(32 * kn + 4 * i) * (NQKV * 2) + koff); vraw[i] = *(const v4u*)(vbase + (size_t)(16 * i * SEQ + 32 * kn) * 2 + voff); } }
            f32x16 x;
#pragma unroll
            for (int i = 0; i < 16; ++i) x[i] = 0.f;
#pragma unroll
            for (int s = 0; s < 8; ++s) { const bf16x8 kf = *(const LAS bf16x8*)(kbuf + r * AT_KSTR + 32 * s + 16 * h); x = MFMA32(kf, qf[s], x); }
            asm volatile("s_nop 7" ::: "memory");
            float lk[16], lb[16];
#pragma unroll
            for (int i = 0; i < 16; ++i) { const float z = x[i];
                const float sp = fmaxf(z, 0.f) + __builtin_amdgcn_logf(1.0f + __builtin_amdgcn_exp2f(-fabsf(z)));
                const int key = k0 + (i & 3) + 8 * (i >> 2) + 4 * h;
                lk[i] = (key < tq) ? -sp : 0.f; lb[i] = z - sp; }
            float gs[4], gp[4], e0[4], e1[4], e2[4];
#pragma unroll
            for (int g = 0; g < 4; ++g) { e2[g] = lk[4 * g + 3]; e1[g] = e2[g] + lk[4 * g + 2]; e0[g] = e1[g] + lk[4 * g + 1]; gs[g] = e0[g] + lk[4 * g]; gp[g] = __shfl_xor(gs[g], 32); }
            const float T0 = gs[0] + gp[0], T1 = gs[1] + gp[1], T2 = gs[2] + gp[2], T3 = gs[3] + gp[3];
            float base[4]; base[3] = R; base[2] = R + T3; base[1] = base[2] + T2; base[0] = base[1] + T1;
            const float total = (base[0] - R) + T0;
            float w[16];
#pragma unroll
            for (int g = 0; g < 4; ++g) { const float bg = base[g] + (h == 0 ? gp[g] : 0.f);
                const float s0 = bg + e0[g], s1 = bg + e1[g], s2 = bg + e2[g], s3 = bg;
                const int key = k0 + 8 * g + 4 * h;
                w[4 * g + 0] = (key + 0 < tq) ? __builtin_amdgcn_exp2f(lb[4 * g + 0] + s0) : 0.f;
                w[4 * g + 1] = (key + 1 < tq) ? __builtin_amdgcn_exp2f(lb[4 * g + 1] + s1) : 0.f;
                w[4 * g + 2] = (key + 2 < tq) ? __builtin_amdgcn_exp2f(lb[4 * g + 2] + s2) : 0.f;
                w[4 * g + 3] = (key + 3 < tq) ? __builtin_amdgcn_exp2f(lb[4 * g + 3] + s3) : 0.f; }
            R += total;
#pragma unroll
            for (int s = 0; s < 2; ++s) { v4u pw; pw.x = pk_bf16(w[8 * s], w[8 * s + 1]); pw.y = pk_bf16(w[8 * s + 2], w[8 * s + 3]); pw.z = pk_bf16(w[8 * s + 4], w[8 * s + 5]); pw.w = pk_bf16(w[8 * s + 6], w[8 * s + 7]);
                const bf16x8 xs = __builtin_bit_cast(bf16x8, pw);
#pragma unroll
                for (int dt = 0; dt < 4; ++dt) { const LAS unsigned char* vp = vbuf + (32 * dt + r) * AT_VSTR + 32 * s + 8 * h; const v2u lo = *(const LAS v2u*)vp, hi = *(const LAS v2u*)(vp + 16);
                    v4u pv; pv.x = lo.x; pv.y = lo.y; pv.z = hi.x; pv.w = hi.y;
                    o[dt] = MFMA32(__builtin_bit_cast(bf16x8, pv), xs, o[dt]); } }
            LDS_WAIT();
            if (__ballot(R > -152.0f) == 0ull) break;
        }
        asm volatile("s_nop 15" ::: "memory");
        bf16* orow = O + (size_t)(b * SEQ + q0 + r) * D + hh * HD + 4 * h;
#pragma unroll
        for (int dt = 0; dt < 4; ++dt)
#pragma unroll
            for (int g = 0; g < 4; ++g) { v2u w2; w2.x = pk_bf16(o[dt][4 * g], o[dt][4 * g + 1]); w2.y = pk_bf16(o[dt][4 * g + 2], o[dt][4 * g + 3]); *(v2u*)(orow + 32 * dt + 8 * g) = w2; }
    }
}

#define XB_TMO      128
#define XB_XCNT(j)  (256  + 64 * (j))
#define XB_XSUB(j)  (1280 + 64 * (j))
#define XB_XGEN(j)  (2304 + 64 * (j))
#define XB_TOP      3328
#define XB_TOPGEN   3392
#define XCD_BAR_WORDS 3456
#define XB_SPIN_CAP (1u << 18)

__device__ __forceinline__ unsigned xb_ld(unsigned* p)              { return __hip_atomic_load(p, __ATOMIC_RELAXED, __HIP_MEMORY_SCOPE_AGENT); }
__device__ __forceinline__ unsigned xb_add(unsigned* p, unsigned v) { return __hip_atomic_fetch_add(p, v, __ATOMIC_RELAXED, __HIP_MEMORY_SCOPE_AGENT); }
__device__ __forceinline__ unsigned xb_xcc_id() { return (unsigned)__builtin_amdgcn_s_getreg((3 << 11) | 20) & 0xFu; }
#define XB_SPIN(cond, bar) do { unsigned _sp = 0; while (cond) { __builtin_amdgcn_s_sleep(1); \
    if ((++_sp & 255u) == 0u) { if (xb_ld(&(bar)[XB_TMO])) break; if (_sp > XB_SPIN_CAP) { atomicAdd(&(bar)[XB_TMO], 1u); break; } } } } while (0)

struct XcdBarrier {
    unsigned* bar; unsigned x;
    volatile LAS unsigned* st;
};

__device__ __forceinline__ XcdBarrier xcd_barrier_post(unsigned* bar, volatile LAS unsigned* st) {
    XcdBarrier b; b.bar = bar; b.x = xb_xcc_id(); b.st = st;
    if (threadIdx.x == 0) (void)xb_add(&bar[XB_XCNT(b.x)], 1u);
    return b;
}
__device__ __forceinline__ void xcd_barrier_complete(unsigned* bar, unsigned x, unsigned& nloc, unsigned& nx) {
    const unsigned G = gridDim.x * gridDim.y * gridDim.z;
    unsigned sum, cnt, mine, sp = 0u;
    for (;;) {
        sum = 0u; cnt = 0u; mine = 0u;
#pragma unroll
        for (unsigned j = 0; j < 16; ++j) { const unsigned c = xb_ld(&bar[XB_XCNT(j)]); sum += c; cnt += (c > 0u) ? 1u : 0u; mine = (j == x) ? c : mine; }
        if (sum == G) break;
        __builtin_amdgcn_s_sleep(1);
        if ((++sp & 255u) == 0u) { if (xb_ld(&bar[XB_TMO])) break; if (sp > XB_SPIN_CAP) { atomicAdd(&bar[XB_TMO], 1u); break; } }
    }
    nloc = mine > 0u ? mine : 1u; nx = cnt > 0u ? cnt : 1u;
}

__device__ __forceinline__ void xcd_barrier(const XcdBarrier& b) {
    asm volatile("s_waitcnt vmcnt(0)" ::: "memory");
    __syncthreads();
    if (threadIdx.x == 0) {
        unsigned* bar = b.bar;
        __builtin_amdgcn_s_waitcnt(0);
        unsigned nloc = b.st[0], nx = b.st[1];
        if (nloc == 0u) { xcd_barrier_complete(bar, b.x, nloc, nx); b.st[0] = nloc; b.st[1] = nx; }
        const unsigned old = xb_add(&bar[XB_XSUB(b.x)], 1u);
        const unsigned gen = old / nloc;
        if (old + 1u == (gen + 1u) * nloc) {
            __builtin_amdgcn_fence(__ATOMIC_RELEASE, "agent");
            asm volatile("s_waitcnt vmcnt(0)" ::: "memory");
            const unsigned og = xb_add(&bar[XB_TOP], 1u);
            const unsigned tg = og / nx;
            if (og + 1u == (tg + 1u) * nx) xb_add(&bar[XB_TOPGEN], 1u);
            else XB_SPIN(xb_ld(&bar[XB_TOPGEN]) == tg, bar);
            __builtin_amdgcn_fence(__ATOMIC_ACQUIRE, "agent");
            xb_add(&bar[XB_XGEN(b.x)], 1u);
            asm volatile("s_waitcnt vmcnt(0)" ::: "memory");
        } else {
            XB_SPIN(xb_ld(&bar[XB_XGEN(b.x)]) == gen, bar);
            __builtin_amdgcn_fence(__ATOMIC_ACQUIRE, "agent");
            asm volatile("s_waitcnt vmcnt(0)" ::: "memory");
        }
    }
    __syncthreads();
}

constexpr int NPH = 17;
enum { T_P0 = 0, T_UP, T_DOWN, T_NORM, T_WIN, T_S5A, T_S5B, T_GLU, T_WOUT, T_QKV, T_PREP, T_ATTN, T_WO };
__global__ void __launch_bounds__(NTHREADS, 2) fwd_megakernel(Params P) {
    extern __shared__ __attribute__((aligned(16))) unsigned char lds_raw[];
    LAS unsigned char* lds = (LAS unsigned char*)lds_raw;
    cg::grid_group grid = cg::this_grid();
    volatile LAS unsigned* bst = (volatile LAS unsigned*)(lds + LDS_MISC);
    if (threadIdx.x < 4) bst[threadIdx.x] = 0u;
    __syncthreads();
    XcdBarrier xbar; xbar.bar = (unsigned*)(P.ws + WS_BAR); xbar.x = 0; xbar.st = bst;
    if (!MK_MULTI) xbar = xcd_barrier_post((unsigned*)(P.ws + WS_BAR), bst);
    for (int ph = P.ph_lo; ph < P.ph_hi; ++ph) {
        int tid = threadIdx.x; asm volatile("" : "+v"(tid));
        const int lane = tid & 63, wave = __builtin_amdgcn_readfirstlane(tid >> 6);
        const int G = gridDim.x, gw = blockIdx.x * NWAVES + wave, NGW = G * NWAVES;
        unsigned char* ws = P.ws;
        bf16* Hb = (bf16*)(ws + WS_H);
        int type, idx = 0;
        int ssi = 0, sso = 6;
        switch (ph) {
            case 0: type = T_P0; break;
            case 1: type = T_UP; idx = 0; ssi = 0; break;   case 2: type = T_DOWN; idx = 0; sso = 1; break;
            case 3: type = T_WIN; ssi = 1; break; case 4: type = T_S5A; break; case 5: type = T_S5B; break; case 6: type = T_GLU; break; case 7: type = T_WOUT; sso = 2; break;
            case 8: type = T_UP; idx = 1; ssi = 2; break;   case 9: type = T_DOWN; idx = 1; sso = 3; break;
            case 10: type = T_UP; idx = 2; ssi = 3; break;  case 11: type = T_DOWN; idx = 2; sso = 4; break;
            case 12: type = T_QKV; ssi = 4; break; case 13: type = T_ATTN; break; case 14: type = T_WO; sso = 5; break;
            case 15: type = T_UP; idx = 3; ssi = 5; break;  default: type = T_DOWN; idx = 3; break;
        }
        const float* SSi = (const float*)(ws + WS_SS) + (size_t)ssi * M; float* SSo = (float*)(ws + WS_SS) + (size_t)sso * M;
        if (type == T_P0) p0_phase(P, lds, gw, NGW, wave, lane);
        else if (type == T_UP) {
            pg8::Gemm g{Hb, (const bf16*)(ws + WS_WGU + (size_t)idx * FFN_SET_BYTES), M, 2 * FF, D}; pg8::StaticOrder S; S.init(M, 2 * FF, G, (int)blockIdx.x);
            pg8::EpiSwiGLU E{(bf16*)(ws + WS_BIG), FF, SSi, lds};
            pg8::gemm_phase<pg8::EpiSwiGLU, pg8::StaticOrder, true, true>(lds, g, S, E, tid);
        } else if (type == T_DOWN || type == T_WOUT || type == T_WO) {
            const bf16* A = type == T_DOWN ? (const bf16*)(ws + WS_BIG) : (const bf16*)(ws + WS_T2);
            const bf16* Bt = type == T_DOWN ? (const bf16*)(ws + WS_WGU + (size_t)idx * FFN_SET_BYTES + WGU_BYTES) : type == T_WOUT ? (const bf16*)(ws + WS_WOUT) : (const bf16*)(ws + WS_WO);
            const int K = type == T_DOWN ? FF : D;
            pg8::Gemm g{A, Bt, M, D, K}; pg8::StaticOrder S; S.init(M, D, G, (int)blockIdx.x, 4);
            pg8::EpiRes E{ph == NPH - 1 ? P.out : nullptr, D, type == T_DOWN ? 1 : 0, Hb, SSo};
            pg8::gemm_phase<pg8::EpiRes, pg8::StaticOrder, true, true>(lds, g, S, E, tid);
        } else if (type == T_WIN) {
            pg8::Gemm g{Hb, (const bf16*)(ws + WS_WIN), M, D, D}; pg8::StaticOrder S; S.init(M, D, G, (int)blockIdx.x);
            pg8::EpiBf16 E{(bf16*)(ws + WS_BIG), D, SSi, lds};
            pg8::gemm_phase<pg8::EpiBf16, pg8::StaticOrder, true, true>(lds, g, S, E, tid);
        } else if (type == T_S5A) s5_pass_a2(P, lds, gw, NGW, wave, lane);
        else if (type == T_S5B) s5_pass_b2(P, lds, gw, NGW, wave, lane);
        else if (type == T_GLU) {
            pg8::Gemm g{(const bf16*)(ws + WS_T1), (const bf16*)(ws + WS_WGLU), M, D, D}; pg8::StaticOrder S; S.init(M, D, G, (int)blockIdx.x);
            pg8::EpiGlu E{(const bf16*)(ws + WS_T1), (bf16*)(ws + WS_T2), D, P.in[I_BGLU]};
            pg8::gemm_phase<pg8::EpiGlu, pg8::StaticOrder, true, true>(lds, g, S, E, tid);
        } else if (type == T_QKV) {
            pg8::Gemm g{Hb, (const bf16*)(ws + WS_WQKV), M, NQKV, D}; pg8::StaticOrder S; S.init(M, NQKV, G, (int)blockIdx.x);
            pg8::EpiQKV E{(bf16*)(ws + WS_BIG), NQKV, SSi, lds, P.in[I_GQ], P.in[I_GK], (bf16*)(ws + WS_T1)};
            pg8::gemm_phase<pg8::EpiQKV, pg8::StaticOrder, true, true>(lds, g, S, E, tid);
        } else if (type == T_PREP) sb_prep(P, lds, gw, NGW, wave, lane);
        else if (type == T_ATTN) sb_attn(P, lds, gw, NGW, wave, lane);
        if (ph + 1 < P.ph_hi) { if (ph == 0) grid.sync(); else xcd_barrier(xbar); }
    }
}

extern "C" void kernel_launch(void* const* d_in, const int* in_sizes, int n_in, void* d_out, int out_size, void* d_ws, size_t ws_size, hipStream_t stream) {
    static int grid = 0;
    if (grid == 0) {
        if (n_in != 26 || in_sizes[0] != M * D || out_size != M * D || ws_size < WS_END) { fprintf(stderr, "kernel_launch: unexpected shapes (n_in %d, in0 %d, out %d, ws %zu)\n", n_in, n_in > 0 ? in_sizes[0] : -1, out_size, ws_size); grid = -1; return; }
        int dev = 0, cus = 0, per_cu = 0;
        if (hipGetDevice(&dev) != hipSuccess || hipDeviceGetAttribute(&cus, hipDeviceAttributeMultiprocessorCount, dev) != hipSuccess) { fprintf(stderr, "kernel_launch: device query failed\n"); grid = -1; return; }
        if (hipFuncSetAttribute((const void*)fwd_megakernel, hipFuncAttributeMaxDynamicSharedMemorySize, LDS_BYTES) != hipSuccess) { fprintf(stderr, "kernel_launch: hipFuncSetAttribute failed\n"); grid = -1; return; }
        if (hipOccupancyMaxActiveBlocksPerMultiprocessor(&per_cu, (const void*)fwd_megakernel, NTHREADS, LDS_BYTES) != hipSuccess || per_cu < 1) { fprintf(stderr, "kernel_launch: occupancy query says %d blocks per CU\n", per_cu); per_cu = 1; }
        (void)hipGetLastError();
        grid = cus * per_cu;
        fprintf(stderr, "kernel_launch: grid %d (%d CUs x %d)\n", grid, cus, per_cu);
    }
    if (grid < 0) return;
    Params p{};
    for (int i = 0; i < 26; ++i) p.in[i] = (const float*)d_in[i];
    p.out = (float*)d_out; p.ws = (unsigned char*)d_ws;
#if MK_MULTI
    for (int ph = 0; ph < NPH; ++ph) { p.ph_lo = ph; p.ph_hi = ph + 1;
        hipLaunchKernelGGL(fwd_megakernel, dim3(grid), dim3(NTHREADS), LDS_BYTES, stream, p);
        const hipError_t le = hipPeekAtLastError(); if (le != hipSuccess) { fprintf(stderr, "kernel_launch: launch %d failed: %s\n", ph, hipGetErrorName(le)); break; } }
#else
    p.ph_lo = 0; p.ph_hi = NPH;
    if (hipMemsetAsync((char*)d_ws + WS_BAR, 0, XCD_BAR_WORDS * 4, stream) != hipSuccess) { fprintf(stderr, "kernel_launch: memset failed\n"); return; }
    void* args[] = {&p};
    const hipError_t le = hipLaunchCooperativeKernel((const void*)fwd_megakernel, dim3(grid), dim3(NTHREADS), args, LDS_BYTES, stream);
    if (le != hipSuccess) fprintf(stderr, "kernel_launch: cooperative launch failed: %s (grid %d)\n", hipGetErrorString(le), grid);
#endif
}
```

```cpp
#include <hip/hip_runtime.h>
#include <hip/hip_cooperative_groups.h>
#include <cstdio>
#include <cstdint>
namespace cg = cooperative_groups;
#ifndef MK_MULTI
#define MK_MULTI 0
#endif
namespace pg8 {
#define PG8_LAS __attribute__((address_space(3)))
typedef unsigned short bf16_t;
typedef short bf16x8 __attribute__((ext_vector_type(8)));
typedef float f32x4 __attribute__((ext_vector_type(4)));
typedef unsigned u32x4 __attribute__((ext_vector_type(4)));
constexpr int BM = 256, BK = 64, HALF = 128, HTB = HALF * BK * 2  , STAGE_BYTES = 8 * HTB, NXCD = 8, WGM = 8;

__host__ __device__ __forceinline__ int lds_byte(int r, int c) { const int st = (r >> 4) * 2 + (c >> 5), rr = r & 15, cc = c & 31, ob = rr * 64 + cc * 2; return st * 1024 + (ob ^ (((ob >> 9) & 1) << 5)); }
__host__ __device__ __forceinline__ void stage_rc(int b, int& R, int& C) { const int st = b / 1024, sb = b % 1024, swz = sb ^ (((sb >> 9) & 1) << 5); R = (st >> 1) * 16 + swz / 64; C = (st & 1) * 32 + (swz % 64) / 2; }
__host__ __device__ __forceinline__ int perm32(int rho) { const int n = rho >> 4, i = rho & 15; return 8 * (i >> 2) + 4 * n + (i & 3); }

struct Unit { int pm, pn; };
struct Gemm { const bf16_t* A; const bf16_t* Bt; int M, N, K; };

struct StaticOrder {
    int nM, nN, nwg, G, c, wgm;
    __host__ __device__ void init(int M, int N, int G_, int c_, int wgm_ = WGM) { nM = M / BM; nN = N / BM; nwg = nM * nN; G = G_; c = c_; wgm = wgm_; }
    __host__ __device__ bool next(int i, Unit& u) const {
        const long L = (long)i * G + c; if (L >= nwg) return false;
        int wgid = (int)L; { const int q = nwg / NXCD, r = nwg % NXCD, xcd = wgid % NXCD, off = wgid / NXCD; wgid = (xcd < r ? xcd * (q + 1) : r * (q + 1) + (xcd - r) * q) + off; }
        const int nig = wgm * nN, gid = wgid / nig, fm = gid * wgm, gsz = (nM - fm) < wgm ? (nM - fm) : wgm;
        u.pm = fm + ((wgid % nig) % gsz); u.pn = (wgid % nig) / gsz; return true;
    }
    __device__ __forceinline__ void a_ready(const Unit&) const {}
    __device__ __forceinline__ void done(const Unit&) const {}
};
__device__ __forceinline__ unsigned cvt_pk_bf16(float lo, float hi) { unsigned r; asm volatile("v_cvt_pk_bf16_f32 %0, %1, %2" : "=v"(r) : "v"(lo), "v"(hi)); return r; }
typedef float f32x2 __attribute__((ext_vector_type(2)));
typedef __bf16 bf16x2_t __attribute__((ext_vector_type(2)));
__device__ __forceinline__ unsigned pk_bf16(float lo, float hi) { f32x2 v = {lo, hi}; bf16x2_t b = __builtin_convertvector(v, bf16x2_t); return __builtin_bit_cast(unsigned, b); }
__device__ __forceinline__ float bf_lo(unsigned w) { return __builtin_bit_cast(float, w << 16); }
__device__ __forceinline__ float bf_hi(unsigned w) { return __builtin_bit_cast(float, w & 0xffff0000u); }
__device__ __forceinline__ float sigmoid_fast(float v) { return __builtin_amdgcn_rcpf(1.0f + __builtin_amdgcn_exp2f(-1.44269504089f * v)); }
__device__ __forceinline__ float rstd_val(float ss) { return __builtin_amdgcn_rsqf(ss * (1.0f / 2048.0f) + 1e-6f); }
constexpr int SSLDS_OFF = 131072 + 1024;
struct EpiSwiGLU {
    static constexpr bool PERM = true, AFTER_DRAIN = false, SSPRE = true;
    bf16_t* O; int ldc; const float* SS; PG8_LAS unsigned char* LDSB;
    __device__ __forceinline__ void operator()(const f32x4 (&acc)[2][2][4][2], const Unit& u, int wr, int wc, int fr, int fq) const {
        const int row0 = u.pm * BM + wr * 64 + fr, col0 = u.pn * HALF + wc * 32 + 8 * fq;
        const PG8_LAS float* ssl = (const PG8_LAS float*)(LDSB + SSLDS_OFF);
        float rsv[2][4];
#pragma unroll
        for (int ai = 0; ai < 2; ++ai)
#pragma unroll
            for (int m = 0; m < 4; ++m) rsv[ai][m] = (float)((const PG8_LAS unsigned*)ssl)[ai * HALF + wr * 64 + m * 16 + fr] * (1.0f / 4096.0f);
#pragma unroll
        for (int ai = 0; ai < 2; ++ai)
#pragma unroll
            for (int m = 0; m < 4; ++m) { bf16_t* rowp = O + (size_t)(row0 + ai * HALF + m * 16) * ldc + col0;
                const float rs = rstd_val(rsv[ai][m]);
                float v[8];
#pragma unroll
                for (int n = 0; n < 2; ++n) {
                    const f32x4 g4 = acc[ai][0][m][n] * rs, u4 = acc[ai][1][m][n] * rs, a4 = g4 * (-1.44269504089f), p4 = g4 * u4;
                    f32x4 e4; e4[0] = __builtin_amdgcn_exp2f(a4[0]); e4[1] = __builtin_amdgcn_exp2f(a4[1]); e4[2] = __builtin_amdgcn_exp2f(a4[2]); e4[3] = __builtin_amdgcn_exp2f(a4[3]);
                    const f32x4 d4 = e4 + 1.0f;
                    f32x4 r4; r4[0] = __builtin_amdgcn_rcpf(d4[0]); r4[1] = __builtin_amdgcn_rcpf(d4[1]); r4[2] = __builtin_amdgcn_rcpf(d4[2]); r4[3] = __builtin_amdgcn_rcpf(d4[3]);
                    const f32x4 o4 = p4 * r4;
                    v[4 * n] = o4[0]; v[4 * n + 1] = o4[1]; v[4 * n + 2] = o4[2]; v[4 * n + 3] = o4[3]; }
                u32x4 w; w.x = pk_bf16(v[0], v[1]); w.y = pk_bf16(v[2], v[3]); w.z = pk_bf16(v[4], v[5]); w.w = pk_bf16(v[6], v[7]);
                *(u32x4*)rowp = w; }
    }
};
typedef unsigned u32x2v __attribute__((ext_vector_type(2)));
struct EpiRes {
    static constexpr bool PERM = true, AFTER_DRAIN = false, SSPRE = false;
    float* OUT; int ldc; int half; bf16_t* XB; float* SSo;
    __device__ __forceinline__ void operator()(const f32x4 (&acc)[2][2][4][2], const Unit& u, int wr, int wc, int fr, int fq) const {
        const int row0 = u.pm * BM + wr * 64 + fr, col0 = u.pn * BM + wc * 32 + 8 * fq;
        const float alpha = half ? 0.5f : 1.0f;
#pragma unroll
        for (int ai = 0; ai < 2; ++ai) {
            u32x4 rv[4][2];
#pragma unroll
            for (int m = 0; m < 4; ++m)
#pragma unroll
                for (int bj = 0; bj < 2; ++bj) rv[m][bj] = *(const u32x4*)(XB + (size_t)(row0 + ai * HALF + m * 16) * ldc + col0 + bj * HALF);
#pragma unroll
            for (int m = 0; m < 4; ++m) { const size_t off = (size_t)(row0 + ai * HALF + m * 16) * ldc + col0;
                float ssum = 0.f;
#pragma unroll
                for (int bj = 0; bj < 2; ++bj) { const u32x4 r = rv[m][bj];
                    const f32x4 v0 = (f32x4){bf_lo(r.x), bf_hi(r.x), bf_lo(r.y), bf_hi(r.y)} + acc[ai][bj][m][0] * alpha, v1 = (f32x4){bf_lo(r.z), bf_hi(r.z), bf_lo(r.w), bf_hi(r.w)} + acc[ai][bj][m][1] * alpha;
                    if (OUT) { *(f32x4*)(OUT + off + bj * HALF) = v0; *(f32x4*)(OUT + off + bj * HALF + 4) = v1; }
                    else { u32x4 w; w.x = pk_bf16(v0[0], v0[1]); w.y = pk_bf16(v0[2], v0[3]); w.z = pk_bf16(v1[0], v1[1]); w.w = pk_bf16(v1[2], v1[3]); *(u32x4*)(XB + off + bj * HALF) = w;
                        ssum += ((v0[0] * v0[0] + v0[1] * v0[1]) + (v0[2] * v0[2] + v0[3] * v0[3])) + ((v1[0] * v1[0] + v1[1] * v1[1]) + (v1[2] * v1[2] + v1[3] * v1[3])); } }
                if (!OUT) { ssum += __shfl_xor(ssum, 16); ssum += __shfl_xor(ssum, 32); if (fq == 0) atomicAdd((unsigned*)SSo + row0 + ai * HALF + m * 16, (unsigned)(ssum * 4096.0f + 0.5f)); } }
            asm volatile("" ::: "memory"); }
    }
};
struct EpiF32 {
    static constexpr bool PERM = false, AFTER_DRAIN = false, SSPRE = true;
    float* C; int ldc; const float* SS; PG8_LAS unsigned char* LDSB;
    __device__ __forceinline__ void operator()(const f32x4 (&acc)[2][2][4][2], const Unit& u, int wr, int wc, int fr, int fq) const {
        const int row0 = u.pm * BM + wr * 64 + fr, col0 = u.pn * BM + wc * 32 + 4 * fq;
        const PG8_LAS float* ssl = (const PG8_LAS float*)(LDSB + SSLDS_OFF);
        float rsv[2][4];
#pragma unroll
        for (int ai = 0; ai < 2; ++ai)
#pragma unroll
            for (int m = 0; m < 4; ++m) rsv[ai][m] = (float)((const PG8_LAS unsigned*)ssl)[ai * HALF + wr * 64 + m * 16 + fr] * (1.0f / 4096.0f);
#pragma unroll
        for (int ai = 0; ai < 2; ++ai)
#pragma unroll
            for (int m = 0; m < 4; ++m) { float* rowp = C + (size_t)(row0 + ai * HALF + m * 16) * ldc + col0; const float rs = rstd_val(rsv[ai][m]);
#pragma unroll
                for (int bj = 0; bj < 2; ++bj)
#pragma unroll
                    for (int n = 0; n < 2; ++n) *(f32x4*)(rowp + bj * HALF + n * 16) = acc[ai][bj][m][n] * rs; }
    }
};
struct EpiBf16 {
    static constexpr bool PERM = true, AFTER_DRAIN = false, SSPRE = true;
    bf16_t* O; int ldc; const float* SS; PG8_LAS unsigned char* LDSB;
    __device__ __forceinline__ void operator()(const f32x4 (&acc)[2][2][4][2], const Unit& u, int wr, int wc, int fr, int fq) const {
        const int row0 = u.pm * BM + wr * 64 + fr, col0 = u.pn * BM + wc * 32 + 8 * fq;
        const PG8_LAS float* ssl = (const PG8_LAS float*)(LDSB + SSLDS_OFF);
        float rsv[2][4];
#pragma unroll
        for (int ai = 0; ai < 2; ++ai)
#pragma unroll
            for (int m = 0; m < 4; ++m) rsv[ai][m] = (float)((const PG8_LAS unsigned*)ssl)[ai * HALF + wr * 64 + m * 16 + fr] * (1.0f / 4096.0f);
#pragma unroll
        for (int ai = 0; ai < 2; ++ai)
#pragma unroll
            for (int m = 0; m < 4; ++m) { bf16_t* rowp = O + (size_t)(row0 + ai * HALF + m * 16) * ldc + col0; const float rs = rstd_val(rsv[ai][m]);
#pragma unroll
                for (int bj = 0; bj < 2; ++bj) { const f32x4 v0 = acc[ai][bj][m][0] * rs, v1 = acc[ai][bj][m][1] * rs;
                    u32x4 w; w.x = pk_bf16(v0[0], v0[1]); w.y = pk_bf16(v0[2], v0[3]); w.z = pk_bf16(v1[0], v1[1]); w.w = pk_bf16(v1[2], v1[3]);
                    *(u32x4*)(rowp + bj * HALF) = w; } }
    }
};
constexpr int PART_OFF = 131072 + 2048;
struct EpiQKV {
    static constexpr bool PERM = true, AFTER_DRAIN = false, SSPRE = true;
    bf16_t* O; int ldc; const float* SS; PG8_LAS unsigned char* LDSB; const float* gq; const float* gk; bf16_t* Vt;
    __device__ __forceinline__ void operator()(const f32x4 (&acc)[2][2][4][2], const Unit& u, int wr, int wc, int fr, int fq) const {
        const int row0 = u.pm * BM + wr * 64 + fr, colt = u.pn * BM, which = colt >> 11;
        const PG8_LAS float* ssl = (const PG8_LAS float*)(LDSB + SSLDS_OFF);
        float rsv[2][4];
#pragma unroll
        for (int ai = 0; ai < 2; ++ai)
#pragma unroll
            for (int m = 0; m < 4; ++m) rsv[ai][m] = rstd_val((float)((const PG8_LAS unsigned*)ssl)[ai * HALF + wr * 64 + m * 16 + fr] * (1.0f / 4096.0f));
        if (which < 2) {
            PG8_LAS float* part = (PG8_LAS float*)(LDSB + PART_OFF);
#pragma unroll
            for (int ai = 0; ai < 2; ++ai)
#pragma unroll
                for (int m = 0; m < 4; ++m)
#pragma unroll
                    for (int bj = 0; bj < 2; ++bj) { const float rs = rsv[ai][m]; const f32x4 v0 = acc[ai][bj][m][0] * rs, v1 = acc[ai][bj][m][1] * rs;
                        float s = ((v0[0] * v0[0] + v0[1] * v0[1]) + (v0[2] * v0[2] + v0[3] * v0[3])) + ((v1[0] * v1[0] + v1[1] * v1[1]) + (v1[2] * v1[2] + v1[3] * v1[3]));
                        s += __shfl_xor(s, 16); s += __shfl_xor(s, 32);
                        if (fq == 0) part[((ai * HALF + wr * 64 + m * 16 + fr) * 2 + bj) * 4 + wc] = s; }
            asm volatile("s_waitcnt lgkmcnt(0)" ::: "memory"); __builtin_amdgcn_s_barrier(); asm volatile("" ::: "memory");
            const float* gn = (which ? gk : gq) + wc * 32 + 8 * fq; const f32x4 ga = *(const f32x4*)gn, gb = *(const f32x4*)(gn + 4);
            const float qs = which ? 1.0f : 0.08838834764831845f * 1.4426950408889634f;
#pragma unroll
            for (int ai = 0; ai < 2; ++ai)
#pragma unroll
                for (int m = 0; m < 4; ++m) { bf16_t* rowp = O + (size_t)(row0 + ai * HALF + m * 16) * ldc + colt + wc * 32 + 8 * fq;
#pragma unroll
                    for (int bj = 0; bj < 2; ++bj) { const f32x4 p4 = *(const PG8_LAS f32x4*)(part + ((ai * HALF + wr * 64 + m * 16 + fr) * 2 + bj) * 4);
                        const float hr = rsv[ai][m] * qs * __builtin_amdgcn_rsqf(((p4[0] + p4[1]) + (p4[2] + p4[3])) * (1.0f / 128.0f) + 1e-6f);
                        const f32x4 v0 = acc[ai][bj][m][0] * hr * ga, v1 = acc[ai][bj][m][1] * hr * gb;
                        u32x4 w; w.x = pk_bf16(v0[0], v0[1]); w.y = pk_bf16(v0[2], v0[3]); w.z = pk_bf16(v1[0], v1[1]); w.w = pk_bf16(v1[2], v1[3]);
                        *(u32x4*)(rowp + bj * HALF) = w; } }
        } else {
#pragma unroll
            for (int ai = 0; ai < 2; ++ai)
#pragma unroll
                for (int m = 0; m < 4; ++m) { const int row = row0 + ai * HALF + m * 16, b = row >> 12, tok = row & 4095; const float rs = rsv[ai][m];
#pragma unroll
                    for (int bj = 0; bj < 2; ++bj) { const int head = ((colt - 4096) >> 7) + bj;
                        bf16_t* vp = Vt + ((size_t)((b * 16 + head) * 128 + wc * 32 + 8 * fq)) * 4096 + tok;
#pragma unroll
                        for (int n = 0; n < 2; ++n)
#pragma unroll
                            for (int j = 0; j < 4; ++j) vp[(size_t)(4 * n + j) * 4096] = (bf16_t)(pk_bf16(acc[ai][bj][m][n][j] * rs, 0.f) & 0xffffu); } }
        }
    }
};
struct EpiGlu {
    static constexpr bool PERM = true, AFTER_DRAIN = false, SSPRE = false;
    const bf16_t* Y; bf16_t* O; int ldc; const float* bias;
    __device__ __forceinline__ void operator()(const f32x4 (&acc)[2][2][4][2], const Unit& u, int wr, int wc, int fr, int fq) const {
        const int row0 = u.pm * BM + wr * 64 + fr, col0 = u.pn * BM + wc * 32 + 8 * fq;
        f32x4 bv[2][2];
#pragma unroll
        for (int bj = 0; bj < 2; ++bj)
#pragma unroll
            for (int n = 0; n < 2; ++n) bv[bj][n] = *(const f32x4*)(bias + col0 + bj * HALF + 4 * n);
#pragma unroll
        for (int ai = 0; ai < 2; ++ai) {
            u32x4 yy[4][2];
#pragma unroll
            for (int m = 0; m < 4; ++m)
#pragma unroll
                for (int bj = 0; bj < 2; ++bj) yy[m][bj] = *(const u32x4*)(Y + (size_t)(row0 + ai * HALF + m * 16) * ldc + col0 + bj * HALF);
#pragma unroll
            for (int m = 0; m < 4; ++m) { const size_t off = (size_t)(row0 + ai * HALF + m * 16) * ldc + col0;
#pragma unroll
                for (int bj = 0; bj < 2; ++bj) { const u32x4 yv = yy[m][bj];
                    const f32x4 g0 = acc[ai][bj][m][0] + bv[bj][0], g1 = acc[ai][bj][m][1] + bv[bj][1];
                    u32x4 w;
                    w.x = pk_bf16(bf_lo(yv.x) * sigmoid_fast(g0[0]), bf_hi(yv.x) * sigmoid_fast(g0[1]));
                    w.y = pk_bf16(bf_lo(yv.y) * sigmoid_fast(g0[2]), bf_hi(yv.y) * sigmoid_fast(g0[3]));
                    w.z = pk_bf16(bf_lo(yv.z) * sigmoid_fast(g1[0]), bf_hi(yv.z) * sigmoid_fast(g1[1]));
                    w.w = pk_bf16(bf_lo(yv.w) * sigmoid_fast(g1[2]), bf_hi(yv.w) * sigmoid_fast(g1[3]));
                    *(u32x4*)(O + off + bj * HALF) = w; } }
            asm volatile("" ::: "memory"); }
    }
};
template <class Epi, class Sched, bool ALIGN_EPI = false, bool SP2 = false>
__device__ __forceinline__ void gemm_phase(PG8_LAS unsigned char* lds, const Gemm g, const Sched& S, const Epi& E, const int tid) {
    const int wid = __builtin_amdgcn_readfirstlane(tid >> 6), lane = tid & 63, wr = wid >> 2, wc = wid & 3, fr = lane & 15, fq = lane >> 4;
    const int K = g.K, nt = K / BK;
    unsigned voffA[2], voffB[2];
#pragma unroll
    for (int i = 0; i < 2; ++i) { int R, C; stage_rc(tid * 16 + i * 8192, R, C); const int Rb = Epi::PERM ? ((R & ~31) + perm32(R & 31)) : R;
        voffA[i] = (unsigned)(R * K + C) * 2u; voffB[i] = (unsigned)(Rb * K + C) * 2u; }
    const size_t kstep = (size_t)(BK * 2);
    const size_t hstep = (size_t)HALF * K * 2;
    const size_t tstep = 2 * hstep;
    const unsigned ldsw = (unsigned)wid * 1024u;
    const int aoff = lds_byte(wr * 64 + fr, fq * 8), boff = lds_byte(wc * 32 + fr, fq * 8);
#define PG8_SA(b, h) (((b) * 2 + (h)) * HTB)
#define PG8_SB(b, h) ((4 + (b) * 2 + (h)) * HTB)
#define PG8_STAGE(bufoff, gbase, voff) do { _Pragma("unroll") for (int _i = 0; _i < 2; ++_i) \
        __builtin_amdgcn_global_load_lds((const unsigned*)((const char*)(gbase) + (voff)[_i]), (PG8_LAS unsigned*)(lds + (bufoff) + ldsw + _i * 8192), 16, 0, 0); } while (0)
#define PG8_LDA(dst, b, h) do { _Pragma("unroll") for (int m = 0; m < 4; ++m) _Pragma("unroll") for (int k = 0; k < 2; ++k) dst[m][k] = *(const PG8_LAS bf16x8*)(lds + PG8_SA(b, h) + aoff + m * 2048 + k * 1024); } while (0)
#define PG8_LDB(dst, b, h) do { _Pragma("unroll") for (int n = 0; n < 2; ++n) _Pragma("unroll") for (int k = 0; k < 2; ++k) dst[n][k] = *(const PG8_LAS bf16x8*)(lds + PG8_SB(b, h) + boff + n * 2048 + k * 1024); } while (0)
#define PG8_MMA(ai, bj, At, Bt) do { __builtin_amdgcn_s_setprio(1); _Pragma("unroll") for (int m = 0; m < 4; ++m) _Pragma("unroll") for (int n = 0; n < 2; ++n) _Pragma("unroll") for (int k = 0; k < 2; ++k) \
        acc[ai][bj][m][n] = __builtin_amdgcn_mfma_f32_16x16x32_bf16(Bt[n][k], At[m][k], acc[ai][bj][m][n], 0, 0, 0); __builtin_amdgcn_s_setprio(0); } while (0)
#define PG8_WAIT_V(n) asm volatile("s_waitcnt vmcnt(" #n ")" ::: "memory")
#define PG8_WAIT_L(n) asm volatile("s_waitcnt lgkmcnt(" #n ")" ::: "memory")
#define PG8_BAR __builtin_amdgcn_s_barrier()
#define PG8_SCHED __builtin_amdgcn_sched_barrier(0)
    Unit cur, nxt; int ui = 0;
    if (!S.next(0, cur)) return;
    f32x4 acc[2][2][4][2];
#pragma unroll
    for (int a = 0; a < 2; ++a)
#pragma unroll
        for (int b = 0; b < 2; ++b)
#pragma unroll
            for (int m = 0; m < 4; ++m)
#pragma unroll
                for (int n = 0; n < 2; ++n) acc[a][b][m][n] = (f32x4){0.f, 0.f, 0.f, 0.f};
    bf16x8 At[4][2], B0[2][2], B1[2][2];
    const char* cA = (const char*)g.A + (size_t)cur.pm * tstep; const char* cB = (const char*)g.Bt + (size_t)cur.pn * tstep;
    S.a_ready(cur);
    if constexpr (SP2) {
        PG8_STAGE(PG8_SB(0, 0), cB, voffB); PG8_STAGE(PG8_SB(0, 1), cB + hstep, voffB); PG8_STAGE(PG8_SA(0, 0), cA, voffA); PG8_STAGE(PG8_SA(0, 1), cA + hstep, voffA);
        if (wr == 1) PG8_BAR;
        PG8_WAIT_V(2); PG8_BAR;
        PG8_STAGE(PG8_SB(1, 0), cB + kstep, voffB); PG8_STAGE(PG8_SA(1, 0), cA + kstep, voffA); PG8_STAGE(PG8_SB(1, 1), cB + hstep + kstep, voffB);
        PG8_WAIT_V(6); PG8_BAR;
    } else {
        PG8_STAGE(PG8_SB(0, 0), cB, voffB); PG8_STAGE(PG8_SA(0, 0), cA, voffA); PG8_STAGE(PG8_SB(0, 1), cB + hstep, voffB); PG8_STAGE(PG8_SA(0, 1), cA + hstep, voffA);
        if (wr == 1) PG8_BAR;
        PG8_WAIT_V(4); PG8_BAR;
        PG8_STAGE(PG8_SB(1, 0), cB + kstep, voffB); PG8_STAGE(PG8_SA(1, 0), cA + kstep, voffA); PG8_STAGE(PG8_SB(1, 1), cB + hstep + kstep, voffB);
        PG8_WAIT_V(6); PG8_BAR;
    }
    for (;;) {
        const bool has_next = S.next(ui + 1, nxt);
        const char* nA = has_next ? (const char*)g.A + (size_t)nxt.pm * tstep : cA; const char* nB = has_next ? (const char*)g.Bt + (size_t)nxt.pn * tstep : cB;
        for (int t = 0; t < nt; t += 2) {
            const bool last = (t == nt - 2);
            const char* a1 = cA + (size_t)(t + 1) * kstep;
            const char* a2 = last ? nA : cA + (size_t)(t + 2) * kstep; const char* b2 = last ? nB : cB + (size_t)(t + 2) * kstep;
            const char* a3 = a2 + kstep; const char* b3 = b2 + kstep;
            if (last && has_next) S.a_ready(nxt);
            if constexpr (Epi::SSPRE) { if (last && wid < 4) __builtin_amdgcn_global_load_lds((const unsigned*)(E.SS + cur.pm * BM + wid * 64 + lane), (PG8_LAS unsigned*)(lds + SSLDS_OFF + wid * 256), 4, 0, 0); }
            if constexpr (SP2) {
            PG8_LDB(B0, 0, 0); PG8_LDB(B1, 0, 1); PG8_SCHED; PG8_LDA(At, 0, 0); PG8_STAGE(PG8_SA(1, 1), a1 + hstep, voffA);
            PG8_WAIT_V(8); PG8_WAIT_L(0); PG8_BAR; PG8_MMA(0, 0, At, B0); PG8_MMA(0, 1, At, B1); PG8_BAR; PG8_SCHED;
            PG8_LDA(At, 0, 1); PG8_STAGE(PG8_SB(0, 0), b2, voffB); PG8_STAGE(PG8_SB(0, 1), b2 + hstep, voffB); PG8_STAGE(PG8_SA(0, 0), a2, voffA);
            PG8_WAIT_V(8); PG8_WAIT_L(0); PG8_BAR; PG8_MMA(1, 0, At, B0); PG8_MMA(1, 1, At, B1); PG8_BAR; PG8_SCHED;
            PG8_LDB(B0, 1, 0); PG8_LDB(B1, 1, 1); PG8_SCHED; PG8_LDA(At, 1, 0); PG8_STAGE(PG8_SA(0, 1), a2 + hstep, voffA);
            PG8_WAIT_V(8); PG8_WAIT_L(0); PG8_BAR; PG8_MMA(0, 0, At, B0); PG8_MMA(0, 1, At, B1); PG8_BAR; PG8_SCHED;
            PG8_LDA(At, 1, 1); PG8_STAGE(PG8_SB(1, 0), b3, voffB); PG8_STAGE(PG8_SB(1, 1), b3 + hstep, voffB); PG8_STAGE(PG8_SA(1, 0), a3, voffA);
            PG8_WAIT_V(8); PG8_WAIT_L(0); PG8_BAR; PG8_MMA(1, 0, At, B0); PG8_MMA(1, 1, At, B1); PG8_BAR; PG8_SCHED;
            } else {
            PG8_LDB(B0, 0, 0); PG8_SCHED; PG8_LDA(At, 0, 0); PG8_STAGE(PG8_SA(1, 1), a1 + hstep, voffA);
            PG8_WAIT_L(8); PG8_BAR; PG8_WAIT_L(0); PG8_MMA(0, 0, At, B0); PG8_BAR; PG8_SCHED;
            PG8_LDB(B1, 0, 1); PG8_STAGE(PG8_SB(0, 0), b2, voffB);
            PG8_BAR; PG8_WAIT_L(0); PG8_MMA(0, 1, At, B1); PG8_BAR;
            PG8_LDA(At, 0, 1); PG8_STAGE(PG8_SA(0, 0), a2, voffA);
            PG8_BAR; PG8_WAIT_L(0); PG8_MMA(1, 0, At, B0); PG8_BAR; PG8_SCHED;
            PG8_STAGE(PG8_SB(0, 1), b2 + hstep, voffB);
            PG8_WAIT_V(6); PG8_BAR; PG8_MMA(1, 1, At, B1); PG8_BAR;
            PG8_LDB(B0, 1, 0); PG8_SCHED; PG8_LDA(At, 1, 0); PG8_STAGE(PG8_SA(0, 1), a2 + hstep, voffA);
            PG8_WAIT_L(8); PG8_BAR; PG8_WAIT_L(0); PG8_MMA(0, 0, At, B0); PG8_BAR; PG8_SCHED;
            PG8_LDB(B1, 1, 1); PG8_STAGE(PG8_SB(1, 0), b3, voffB);
            PG8_BAR; PG8_WAIT_L(0); PG8_MMA(0, 1, At, B1); PG8_BAR;
            PG8_LDA(At, 1, 1); PG8_STAGE(PG8_SA(1, 0), a3, voffA);
            PG8_BAR; PG8_WAIT_L(0); PG8_MMA(1, 0, At, B0); PG8_BAR; PG8_SCHED;
            PG8_STAGE(PG8_SB(1, 1), b3 + hstep, voffB);
            PG8_WAIT_V(6); PG8_BAR; PG8_MMA(1, 1, At, B1); PG8_BAR;
            }
        }
        if constexpr (ALIGN_EPI) { if (wr == 0) PG8_BAR; }
        if constexpr (!Epi::AFTER_DRAIN) { E(acc, cur, wr, wc, fr, fq); S.done(cur); }
        if (!has_next) break;
#pragma unroll
        for (int a = 0; a < 2; ++a)
#pragma unroll
            for (int b = 0; b < 2; ++b)
#pragma unroll
                for (int m = 0; m < 4; ++m)
#pragma unroll
                    for (int n = 0; n < 2; ++n) acc[a][b][m][n] = (f32x4){0.f, 0.f, 0.f, 0.f};
        cur = nxt; cA = nA; cB = nB; ++ui;
        if constexpr (ALIGN_EPI) { if (wr == 1) PG8_BAR; }
    }
    PG8_WAIT_V(0);
    if constexpr (!ALIGN_EPI) { if (wr == 0) PG8_BAR; }
    PG8_BAR;
    if constexpr (Epi::AFTER_DRAIN) { E.fused(acc, cur, wr, wc, fr, fq, lds, wid, lane); S.done(cur); }
#undef PG8_SA
#undef PG8_SB
#undef PG8_STAGE
#undef PG8_LDA
#undef PG8_LDB
#undef PG8_MMA
#undef PG8_WAIT_V
#undef PG8_WAIT_L
#undef PG8_BAR
#undef PG8_SCHED
}
}
#define GAS __attribute__((address_space(1)))
#define LAS __attribute__((address_space(3)))
typedef unsigned short bf16;
typedef unsigned v4u __attribute__((ext_vector_type(4)));
typedef unsigned v2u __attribute__((ext_vector_type(2)));
typedef float f32x4 __attribute__((ext_vector_type(4)));
typedef float f32x2 __attribute__((ext_vector_type(2)));
typedef float f32x16 __attribute__((ext_vector_type(16)));
typedef short bf16x8 __attribute__((ext_vector_type(8)));
using pg8::pk_bf16; using pg8::bf_lo; using pg8::bf_hi; using pg8::sigmoid_fast;

constexpr int NWAVES = 8, NTHREADS = NWAVES * 64;
constexpr int BATCH = 4, SEQ = 4096, D = 2048, FF = 5632, M = BATCH * SEQ;
constexpr int S5G = 128, S5H = 16, S5P = 64, CHUNK = 64, NCH = SEQ / CHUNK;
constexpr int NH = 16, HD = 128, NQKV = 3 * D;
constexpr float EPS = 1e-6f;
constexpr size_t MiB = 1u << 20;
constexpr size_t WS_WGU = 0, WGU_BYTES = 44 * MiB, WD_BYTES = 22 * MiB, FFN_SET_BYTES = 66 * MiB;
constexpr size_t WS_WIN = 264 * MiB, WS_WGLU = 272 * MiB, WS_WOUT = 280 * MiB, WS_WQKV = 288 * MiB, WS_WO = 312 * MiB;
constexpr size_t WS_H = 320 * MiB;
constexpr size_t WS_BIG = 384 * MiB;
constexpr size_t WS_T1 = 576 * MiB;
constexpr size_t WS_T2 = 640 * MiB;
constexpr size_t WS_E = 704 * MiB;
constexpr size_t WS_BAR = 720 * MiB;
constexpr size_t WS_SS = 721 * MiB;
constexpr size_t WS_END = 722 * MiB;
constexpr int LDS_BYTES = 147456;
constexpr int LDS_MISC = 147456 - 256;

struct Params { const float* in[26]; float* out; unsigned char* ws; int ph_lo, ph_hi; };
enum { I_X = 0, I_NF1, I_F1G, I_F1U, I_F1D, I_NMIX, I_WIN, I_LRE, I_LIM, I_LDT, I_BRE, I_BIM, I_CRE, I_CIM, I_DSK, I_WGLU, I_BGLU, I_WOUT, I_WQKV, I_GQ, I_GK, I_WO, I_NF2, I_F2G, I_F2U, I_F2D };

#define LDS_WAIT() asm volatile("s_waitcnt lgkmcnt(0)" ::: "memory")

__device__ __forceinline__ void cvt_item(const float* W, int K, int N, bf16* WT, int mode, LAS float* scr, int item, int lane, const float* gain = nullptr) {
    const int nblk = N / 32, kb = item / nblk, nb = item % nblk, k0 = 64 * kb, n0 = 32 * nb;
    const int r0 = (mode == 0) ? n0 : ((n0 >> 7) * 256 + (mode == 2 ? 128 : 0) + (n0 & 127));
#pragma unroll 8
    for (int i = 0; i < 32; ++i) { const int kk = 2 * i + (lane >> 5); scr[kk * 33 + (lane & 31)] = W[(size_t)(k0 + kk) * N + n0 + (lane & 31)]; }
    LDS_WAIT();
    const int c = lane & 7;
    f32x4 ga = {1.f, 1.f, 1.f, 1.f}, gb = ga; if (gain) { ga = *(const f32x4*)(gain + k0 + 8 * c); gb = *(const f32x4*)(gain + k0 + 8 * c + 4); }
#pragma unroll
    for (int j = 0; j < 4; ++j) { const int n = (lane >> 3) + 8 * j; const LAS float* s = scr + (8 * c) * 33 + n;
        v4u o; o.x = pk_bf16(s[0 * 33] * ga.x, s[1 * 33] * ga.y); o.y = pk_bf16(s[2 * 33] * ga.z, s[3 * 33] * ga.w); o.z = pk_bf16(s[4 * 33] * gb.x, s[5 * 33] * gb.y); o.w = pk_bf16(s[6 * 33] * gb.z, s[7 * 33] * gb.w);
        *(v4u*)(WT + (size_t)(r0 + n) * K + k0 + 8 * c) = o; }
    LDS_WAIT();
}
__device__ __forceinline__ float wave_sum(float v) {
#pragma unroll
    for (int o = 1; o < 64; o <<= 1) v += __shfl_xor(v, o);
    return v;
}
__device__ __forceinline__ void norm_row(const float* xrow, const float* gain, bf16* orow, int lane) {
    const f32x4* xr = (const f32x4*)xrow + lane; const f32x4* gr = (const f32x4*)gain + lane;
    f32x4 v[8]; float s = 0.f;
#pragma unroll
    for (int j = 0; j < 8; ++j) { v[j] = xr[64 * j]; s += (v[j].x * v[j].x + v[j].y * v[j].y) + (v[j].z * v[j].z + v[j].w * v[j].w); }
    const float rstd = 1.0f / sqrtf(wave_sum(s) * (1.f / D) + EPS);
    v2u* o8 = (v2u*)orow + lane;
#pragma unroll
    for (int j = 0; j < 8; ++j) { const f32x4 g = gr[64 * j]; v2u w; w.x = pk_bf16(v[j].x * rstd * g.x, v[j].y * rstd * g.y); w.y = pk_bf16(v[j].z * rstd * g.z, v[j].w * rstd * g.w); o8[64 * j] = w; }
}
__device__ __forceinline__ void norm_phase(const float* X, const float* gain, bf16* H, int gw, int NGW, int lane) {
    for (int m = gw; m < M; m += NGW) norm_row(X + (size_t)m * D, gain, H + (size_t)m * D, lane);
}
__device__ __forceinline__ void p0_phase(const Params& P, LAS unsigned char* lds, int gw, int NGW, int wave, int lane) {
    LAS float* scr = (LAS float*)(lds + wave * 16384);
    constexpr int I_G = (D / 64) * (FF / 32), I_DN = (FF / 64) * (D / 32), I_SET = 2 * I_G + I_DN;
    constexpr int I_SQ = (D / 64) * (D / 32), I_QKV = (D / 64) * (NQKV / 32);
    constexpr int NITEMS = 4 * I_SET + 4 * I_SQ + I_QKV;
    unsigned char* ws = P.ws;
    for (int it = gw; it < NITEMS; it += NGW) {
        int r = it;
        if (r < 4 * I_SET) { const int set = r / I_SET; r -= set * I_SET; const int layer = set >> 1, second = set & 1;
            bf16* wgu = (bf16*)(ws + WS_WGU + (size_t)set * FFN_SET_BYTES); bf16* wd = (bf16*)(ws + WS_WGU + (size_t)set * FFN_SET_BYTES + WGU_BYTES);
            const float* g = P.in[second ? I_F2G : I_F1G] + (size_t)layer * D * FF; const float* u = P.in[second ? I_F2U : I_F1U] + (size_t)layer * D * FF; const float* dn = P.in[second ? I_F2D : I_F1D] + (size_t)layer * FF * D;
            const float* gn = P.in[second ? I_NF2 : I_NF1] + layer * D;
            if (r < I_G) { cvt_item(g, D, FF, wgu, 1, scr, r, lane, gn); continue; } r -= I_G;
            if (r < I_G) { cvt_item(u, D, FF, wgu, 2, scr, r, lane, gn); continue; } r -= I_G;
            cvt_item(dn, FF, D, wd, 0, scr, r, lane); continue; }
        r -= 4 * I_SET;
        if (r < I_SQ) { cvt_item(P.in[I_WIN], D, D, (bf16*)(ws + WS_WIN), 0, scr, r, lane, P.in[I_NMIX]); continue; } r -= I_SQ;
        if (r < I_SQ) { cvt_item(P.in[I_WGLU], D, D, (bf16*)(ws + WS_WGLU), 0, scr, r, lane); continue; } r -= I_SQ;
        if (r < I_SQ) { cvt_item(P.in[I_WOUT], D, D, (bf16*)(ws + WS_WOUT), 0, scr, r, lane); continue; } r -= I_SQ;
        if (r < I_SQ) { cvt_item(P.in[I_WO], D, D, (bf16*)(ws + WS_WO), 0, scr, r, lane); continue; } r -= I_SQ;
        cvt_item(P.in[I_WQKV], D, NQKV, (bf16*)(ws + WS_WQKV), 0, scr, r, lane, P.in[I_NMIX] + D);
    }
    float* SS = (float*)(ws + WS_SS);
    for (int i = gw * 64 + lane; i < 6 * M; i += NGW * 64) SS[M + i] = 0.f;
    for (int m = gw; m < M; m += NGW) {
        const f32x4* xr = (const f32x4*)(P.in[I_X] + (size_t)m * D) + lane; v2u* o8 = (v2u*)((bf16*)(ws + WS_H) + (size_t)m * D) + lane; float s = 0.f;
#pragma unroll
        for (int j = 0; j < 8; ++j) { const f32x4 v = xr[64 * j]; s += (v.x * v.x + v.y * v.y) + (v.z * v.z + v.w * v.w); v2u w; w.x = pk_bf16(v.x, v.y); w.y = pk_bf16(v.z, v.w); o8[64 * j] = w; }
        s = wave_sum(s); if (lane == 0) ((unsigned*)SS)[m] = (unsigned)(s * 4096.0f + 0.5f); }
}

__device__ __forceinline__ void sincos_acc(float x, float& s, float& c) {
    const float jf = rintf(x * 0.636619772f); const int j = (int)jf;
    float y = fmaf(-jf, 1.5703125f, x); y = fmaf(-jf, 4.837512969970703125e-4f, y); y = fmaf(-jf, 7.54978995489188216e-8f, y);
    const float z = y * y;
    const float sp = fmaf(fmaf(fmaf(-1.9515295891e-4f, z, 8.3321608736e-3f), z, -1.6666654611e-1f) * z, y, y);
    const float cp = fmaf(fmaf(fmaf(2.443315711809948e-5f, z, -1.388731625493765e-3f), z, 4.166664568298827e-2f), z * z, fmaf(-0.5f, z, 1.0f));
    const int q = j & 3;
    const float ss = (q & 1) ? cp : sp, cc = (q & 1) ? sp : cp;
    s = (q & 2) ? -ss : ss; c = ((q + 1) & 2) ? -cc : cc;
}
__device__ __forceinline__ void s5_setup(const Params& P, int g, int p, float& are, float& aim, f32x2 (&bb)[16]) {
    const float dt = expf(P.in[I_LDT][g]);
    const float lr = fminf(P.in[I_LRE][g * S5P + p], -1e-4f), li = P.in[I_LIM][g * S5P + p];
    const float mag = expf(lr * dt); float sn, cs; sincos_acc(li * dt, sn, cs);
    are = mag * cs; aim = mag * sn;
    const float den = lr * lr + li * li, nre = are - 1.0f;
    const float fre = (nre * lr + aim * li) / den, fim = (aim * lr - nre * li) / den;
    const f32x4* br = (const f32x4*)(P.in[I_BRE] + (size_t)(g * S5P + p) * S5H); const f32x4* bi = (const f32x4*)(P.in[I_BIM] + (size_t)(g * S5P + p) * S5H);
#pragma unroll
    for (int q = 0; q < 4; ++q) { const f32x4 r4 = br[q], i4 = bi[q];
#pragma unroll
        for (int e = 0; e < 4; ++e) { bb[4 * q + e].x = fre * r4[e] - fim * i4[e]; bb[4 * q + e].y = fre * i4[e] + fim * r4[e]; } }
}
__device__ __forceinline__ void s5_load_u(const float* U, int row0, int g, int lane, f32x4 (&pre)[4]) {
    const f32x4* src = (const f32x4*)(U + (size_t)(row0 + lane) * D + g * S5H);
    pre[0] = src[0]; pre[1] = src[1]; pre[2] = src[2]; pre[3] = src[3];
}
__device__ __forceinline__ void s5_put_u(LAS float* ubuf, int lane, const f32x4 (&pre)[4]) {
    LAS f32x4* dst = (LAS f32x4*)(ubuf + lane * 16);
    dst[0] = pre[0]; dst[1] = pre[1]; dst[2] = pre[2]; dst[3] = pre[3];
    LDS_WAIT();
}
__device__ __forceinline__ void s5_step(const LAS float* urow, const f32x2 (&bb)[16], float are, float aim, float& sre, float& sim) {
    const LAS f32x4* u4 = (const LAS f32x4*)urow;
    f32x2 bu = {0.f, 0.f};
#pragma unroll
    for (int q = 0; q < 4; ++q) { const f32x4 uu = u4[q];
#pragma unroll
        for (int e = 0; e < 4; ++e) { const f32x2 ub = {uu[e], uu[e]}; bu += bb[4 * q + e] * ub; } }
    const float nre = fmaf(are, sre, fmaf(-aim, sim, bu.x)), nim = fmaf(are, sim, fmaf(aim, sre, bu.y));
    sre = nre; sim = nim;
}
template <bool STORE>
__device__ __forceinline__ void s5_step4(const LAS float* urow, const f32x2 (&bb)[16], float are, float aim, float& sre, float& sim, LAS unsigned char* sw) {
    f32x4 uu[4][4];
#pragma unroll
    for (int s = 0; s < 4; ++s)
#pragma unroll
        for (int q = 0; q < 4; ++q) uu[s][q] = ((const LAS f32x4*)(urow + s * 16))[q];
    f32x2 acc[4][2];
#pragma unroll
    for (int s = 0; s < 4; ++s) { acc[s][0] = (f32x2){0.f, 0.f}; acc[s][1] = (f32x2){0.f, 0.f}; }
#pragma unroll
    for (int q = 0; q < 4; ++q)
#pragma unroll
        for (int e = 0; e < 4; ++e)
#pragma unroll
            for (int s = 0; s < 4; ++s) { const float uv = uu[s][q][e]; const f32x2 ub = {uv, uv}; acc[s][e & 1] += bb[4 * q + e] * ub; }
#pragma unroll
    for (int s = 0; s < 4; ++s) { const f32x2 bu = acc[s][0] + acc[s][1];
        const float nre = fmaf(are, sre, fmaf(-aim, sim, bu.x)), nim = fmaf(are, sim, fmaf(aim, sre, bu.y)); sre = nre; sim = nim;
        if (STORE) *(LAS unsigned*)(sw + s * 272) = pk_bf16(sre, sim); }
}
constexpr int NQ = 4, QLEN = SEQ / NQ, CPQ = QLEN / CHUNK;
__device__ __forceinline__ void s5_pass_a(const Params& P, LAS unsigned char* lds, int gw, int NGW, int wave, int lane) {
    LAS float* ubuf = (LAS float*)(lds + wave * 16384);
    const float* U = (const float*)(P.ws + WS_BIG); f32x2* E = (f32x2*)(P.ws + WS_E);
    for (int task = gw; task < BATCH * S5G * (NQ - 1); task += NGW) {
        const int g = task % S5G, b = (task / S5G) % BATCH, q = task / (S5G * BATCH);
        float are, aim; f32x2 bb[16]; s5_setup(P, g, lane, are, aim, bb);
        float sre = 0.f, sim = 0.f;
        f32x4 pre[4]; s5_load_u(U, b * SEQ + q * QLEN, g, lane, pre);
#pragma unroll 1
        for (int c = 0; c < CPQ; ++c) {
            s5_put_u(ubuf, lane, pre);
            s5_load_u(U, b * SEQ + q * QLEN + (c + 1 < CPQ ? c + 1 : c) * CHUNK, g, lane, pre);
#pragma unroll 2
            for (int t = 0; t < CHUNK; t += 4) s5_step4<false>(ubuf + t * 16, bb, are, aim, sre, sim, nullptr);
            LDS_WAIT();
        }
        E[((size_t)(b * NQ + q) * S5G + g) * S5P + lane] = (f32x2){sre, sim};
    }
}
__device__ __forceinline__ float gelu_tanh(float y) { const float z = 0.7978845608028654f * (y + 0.044715f * y * y * y); return y * sigmoid_fast(2.0f * z); }
__device__ __forceinline__ void s5_pass_b(const Params& P, LAS unsigned char* lds, int gw, int NGW, int wave, int lane) {
    LAS float* ubuf = (LAS float*)(lds + wave * 16384);
    LAS unsigned char* sbuf = lds + wave * 16384 + 4096;
    const float* U = (const float*)(P.ws + WS_BIG); const f32x2* E = (const f32x2*)(P.ws + WS_E); bf16* Y = (bf16*)(P.ws + WS_T1);
    const int fr = lane & 15, fq = lane >> 4;
    for (int task = gw; task < BATCH * S5G * NQ; task += NGW) {
        const int g = task % S5G, b = (task / S5G) % BATCH, q = task / (S5G * BATCH);
        float are, aim; f32x2 bb[16]; s5_setup(P, g, lane, are, aim, bb);
        float aqr = are, aqi = aim;
#pragma unroll
        for (int i = 0; i < 10; ++i) { const float nr = aqr * aqr - aqi * aqi, ni = 2.0f * aqr * aqi; aqr = nr; aqi = ni; }
        float sre = 0.f, sim = 0.f;
        for (int q2 = 0; q2 < q; ++q2) { const f32x2 e = E[((size_t)(b * NQ + q2) * S5G + g) * S5P + lane];
            const float nr = fmaf(aqr, sre, fmaf(-aqi, sim, e.x)), ni = fmaf(aqr, sim, fmaf(aqi, sre, e.y)); sre = nr; sim = ni; }
        bf16x8 ac[4];
#pragma unroll
        for (int ks = 0; ks < 4; ++ks) { const f32x4 cr = *(const f32x4*)(P.in[I_CRE] + (size_t)(g * S5H + fr) * S5P + 16 * ks + 4 * fq), ci = *(const f32x4*)(P.in[I_CIM] + (size_t)(g * S5H + fr) * S5P + 16 * ks + 4 * fq);
            v4u w; w.x = pk_bf16(cr.x, -ci.x); w.y = pk_bf16(cr.y, -ci.y); w.z = pk_bf16(cr.z, -ci.z); w.w = pk_bf16(cr.w, -ci.w); ac[ks] = __builtin_bit_cast(bf16x8, w); }
        const f32x4 dsk = *(const f32x4*)(P.in[I_DSK] + g * S5H + 4 * fq);
        f32x4 pre[4]; s5_load_u(U, b * SEQ + q * QLEN, g, lane, pre);
#pragma unroll 1
        for (int c = 0; c < CPQ; ++c) {
            const int row0 = b * SEQ + q * QLEN + c * CHUNK;
            s5_put_u(ubuf, lane, pre);
            s5_load_u(U, b * SEQ + q * QLEN + (c + 1 < CPQ ? c + 1 : c) * CHUNK, g, lane, pre);
#pragma unroll 1
            for (int half = 0; half < 2; ++half) {
#pragma unroll 2
                for (int tt = 0; tt < 32; tt += 4) s5_step4<true>(ubuf + (half * 32 + tt) * 16, bb, are, aim, sre, sim, sbuf + tt * 272 + 4 * lane);
                LDS_WAIT();
#pragma unroll
                for (int tile = 0; tile < 2; ++tile) { f32x4 acc = {0.f, 0.f, 0.f, 0.f};
#pragma unroll
                    for (int ks = 0; ks < 4; ++ks) { const bf16x8 sb = *(const LAS bf16x8*)(sbuf + (tile * 16 + fr) * 272 + 64 * ks + 16 * fq);
                        acc = __builtin_amdgcn_mfma_f32_16x16x32_bf16(ac[ks], sb, acc, 0, 0, 0); }
                    const int t = half * 32 + tile * 16 + fr;
                    const f32x4 uu = *(const LAS f32x4*)(ubuf + t * 16 + 4 * fq);
                    v2u w; w.x = pk_bf16(gelu_tanh(acc[0] + dsk[0] * uu[0]), gelu_tanh(acc[1] + dsk[1] * uu[1])); w.y = pk_bf16(gelu_tanh(acc[2] + dsk[2] * uu[2]), gelu_tanh(acc[3] + dsk[3] * uu[3]));
                    *(v2u*)(Y + (size_t)(row0 + t) * D + g * S5H + 4 * fq) = w; }
                LDS_WAIT();
            }
        }
    }
}


constexpr int S5W = 17920, S5_UB = 0, S5_BU = 2048, S5_PLANE = 64 * 80, S5_SB = S5_BU + 2 * S5_PLANE;
static_assert(S5_SB + 16 * 272 <= S5W, "S5 LDS map");
__device__ __forceinline__ void s5_disc(const Params& P, int g, int p, float& are, float& aim, float& fre, float& fim) {
    const float dt = expf(P.in[I_LDT][g]);
    const float lr = fminf(P.in[I_LRE][g * S5P + p], -1e-4f), li = P.in[I_LIM][g * S5P + p];
    const float mag = expf(lr * dt); float sn, cs; sincos_acc(li * dt, sn, cs);
    are = mag * cs; aim = mag * sn;
    const float den = lr * lr + li * li, nre = are - 1.0f;
    fre = (nre * lr + aim * li) / den; fim = (aim * lr - nre * li) / den;
}
__device__ __forceinline__ void s5_bops(const Params& P, int g, int fr, int fq, bf16x8 (&bop)[8]) {
    const int hq = fq & 1; const bool live = fq < 2;
#pragma unroll
    for (int pb = 0; pb < 4; ++pb) { const int p = 16 * pb + fr;
        float are, aim, fre, fim; s5_disc(P, g, p, are, aim, fre, fim);
        const f32x4* br = (const f32x4*)(P.in[I_BRE] + (size_t)(g * S5P + p) * S5H + 8 * hq); const f32x4* bi = (const f32x4*)(P.in[I_BIM] + (size_t)(g * S5P + p) * S5H + 8 * hq);
        const f32x4 r0 = br[0], r1 = br[1], i0 = bi[0], i1 = bi[1];
        float re[8], im[8];
#pragma unroll
        for (int e = 0; e < 4; ++e) { re[e] = fre * r0[e] - fim * i0[e]; im[e] = fre * i0[e] + fim * r0[e]; re[4 + e] = fre * r1[e] - fim * i1[e]; im[4 + e] = fre * i1[e] + fim * r1[e]; }
        v4u wr, wi; wr.x = pk_bf16(re[0], re[1]); wr.y = pk_bf16(re[2], re[3]); wr.z = pk_bf16(re[4], re[5]); wr.w = pk_bf16(re[6], re[7]);
        wi.x = pk_bf16(im[0], im[1]); wi.y = pk_bf16(im[2], im[3]); wi.z = pk_bf16(im[4], im[5]); wi.w = pk_bf16(im[6], im[7]);
        if (!live) { wr = (v4u){0u, 0u, 0u, 0u}; wi = wr; }
        bop[2 * pb] = __builtin_bit_cast(bf16x8, wr); bop[2 * pb + 1] = __builtin_bit_cast(bf16x8, wi); }
}
__device__ __forceinline__ void s5_load_ub(const bf16* U, int row0, int g, int lane, v4u (&pre)[2]) {
    const v4u* src = (const v4u*)(U + (size_t)(row0 + lane) * D + g * S5H); pre[0] = src[0]; pre[1] = src[1];
}
__device__ __forceinline__ void s5_put_ub(LAS unsigned char* ub, int lane, const v4u (&pre)[2]) {
    *(LAS v4u*)(ub + lane * 32) = pre[0]; *(LAS v4u*)(ub + lane * 32 + 16) = pre[1];
    LDS_WAIT();
}
__device__ __forceinline__ void s5_put_u_bf16(LAS unsigned char* ub, int lane, const f32x4 (&pre)[4]) {
    v4u a, b; a.x = pk_bf16(pre[0].x, pre[0].y); a.y = pk_bf16(pre[0].z, pre[0].w); a.z = pk_bf16(pre[1].x, pre[1].y); a.w = pk_bf16(pre[1].z, pre[1].w);
    b.x = pk_bf16(pre[2].x, pre[2].y); b.y = pk_bf16(pre[2].z, pre[2].w); b.z = pk_bf16(pre[3].x, pre[3].y); b.w = pk_bf16(pre[3].z, pre[3].w);
    *(LAS v4u*)(ub + lane * 32) = a; *(LAS v4u*)(ub + lane * 32 + 16) = b;
    LDS_WAIT();
}
__device__ __forceinline__ void s5_bu16(LAS unsigned char* wl, int t0, int fr, int fq, const bf16x8 (&bop)[8]) {
    v4u araw = *(const LAS v4u*)(wl + S5_UB + (t0 + fr) * 32 + 16 * (fq & 1)); if (fq >= 2) araw = (v4u){0u, 0u, 0u, 0u};
    const bf16x8 af = __builtin_bit_cast(bf16x8, araw);
    f32x4 acc[8];
#pragma unroll
    for (int nt = 0; nt < 8; ++nt) { acc[nt] = (f32x4){0.f, 0.f, 0.f, 0.f};
        acc[nt] = __builtin_amdgcn_mfma_f32_16x16x32_bf16(af, bop[nt], acc[nt], 0, 0, 0); }
    asm volatile("s_nop 15\n\ts_nop 15" : "+v"(acc[0]), "+v"(acc[1]), "+v"(acc[2]), "+v"(acc[3]), "+v"(acc[4]), "+v"(acc[5]), "+v"(acc[6]), "+v"(acc[7]) :: "memory");
#pragma unroll
    for (int nt = 0; nt < 8; ++nt) *(LAS f32x4*)(wl + S5_BU + (nt & 1) * S5_PLANE + (16 * (nt >> 1) + fr) * 80 + 16 * fq) = acc[nt];
    asm volatile("" :: "v"(af));
    LDS_WAIT();
}
template <bool STORE>
__device__ __forceinline__ void s5_scan16(LAS unsigned char* wl, int lane, float are, float aim, float& sre, float& sim) {
    f32x4 re4[4], im4[4];
#pragma unroll
    for (int q = 0; q < 4; ++q) { re4[q] = *(const LAS f32x4*)(wl + S5_BU + lane * 80 + 16 * q); im4[q] = *(const LAS f32x4*)(wl + S5_BU + S5_PLANE + lane * 80 + 16 * q); }
#pragma unroll
    for (int q = 0; q < 4; ++q)
#pragma unroll
        for (int e = 0; e < 4; ++e) { const float nre = fmaf(are, sre, fmaf(-aim, sim, re4[q][e])), nim = fmaf(are, sim, fmaf(aim, sre, im4[q][e])); sre = nre; sim = nim;
            if (STORE) *(LAS unsigned*)(wl + S5_SB + (4 * q + e) * 272 + 4 * lane) = pk_bf16(sre, sim); }
    LDS_WAIT();
}
__device__ __forceinline__ void s5_pass_a2(const Params& P, LAS unsigned char* lds, int gw, int NGW, int wave, int lane) {
    LAS unsigned char* wl = lds + wave * S5W;
    const bf16* U = (const bf16*)(P.ws + WS_BIG); f32x2* E = (f32x2*)(P.ws + WS_E);
    const int fr = lane & 15, fq = lane >> 4;
    for (int task = gw; task < BATCH * S5G * (NQ - 1); task += NGW) {
        const int g = task % S5G, b = (task / S5G) % BATCH, q = task / (S5G * BATCH);
        float are, aim, fre, fim; s5_disc(P, g, lane, are, aim, fre, fim);
        bf16x8 bop[8]; s5_bops(P, g, fr, fq, bop);
        float sre = 0.f, sim = 0.f;
        v4u pre[2]; s5_load_ub(U, b * SEQ + q * QLEN, g, lane, pre);
#pragma unroll 1
        for (int c = 0; c < CPQ; ++c) {
            s5_put_ub(wl + S5_UB, lane, pre);
            s5_load_ub(U, b * SEQ + q * QLEN + (c + 1 < CPQ ? c + 1 : c) * CHUNK, g, lane, pre);
#pragma unroll 1
            for (int blk = 0; blk < 4; ++blk) { s5_bu16(wl, 16 * blk, fr, fq, bop); s5_scan16<false>(wl, lane, are, aim, sre, sim); }
        }
        E[((size_t)(b * NQ + q) * S5G + g) * S5P + lane] = (f32x2){sre, sim};
    }
}
__device__ __forceinline__ void s5_pass_b2(const Params& P, LAS unsigned char* lds, int gw, int NGW, int wave, int lane) {
    LAS unsigned char* wl = lds + wave * S5W;
    const bf16* U = (const bf16*)(P.ws + WS_BIG); const f32x2* E = (const f32x2*)(P.ws + WS_E); bf16* Y = (bf16*)(P.ws + WS_T1);
    const int fr = lane & 15, fq = lane >> 4;
    for (int task = gw; task < BATCH * S5G * NQ; task += NGW) {
        const int g = task % S5G, b = (task / S5G) % BATCH, q = task / (S5G * BATCH);
        float are, aim, fre, fim; s5_disc(P, g, lane, are, aim, fre, fim);
        bf16x8 bop[8]; s5_bops(P, g, fr, fq, bop);
        float aqr = are, aqi = aim;
#pragma unroll
        for (int i = 0; i < 10; ++i) { const float nr = aqr * aqr - aqi * aqi, ni = 2.0f * aqr * aqi; aqr = nr; aqi = ni; }
        float sre = 0.f, sim = 0.f;
        for (int q2 = 0; q2 < q; ++q2) { const f32x2 e = E[((size_t)(b * NQ + q2) * S5G + g) * S5P + lane];
            const float nr = fmaf(aqr, sre, fmaf(-aqi, sim, e.x)), ni = fmaf(aqr, sim, fmaf(aqi, sre, e.y)); sre = nr; sim = ni; }
        bf16x8 ac[4];
#pragma unroll
        for (int ks = 0; ks < 4; ++ks) { const f32x4 cr = *(const f32x4*)(P.in[I_CRE] + (size_t)(g * S5H + fr) * S5P + 16 * ks + 4 * fq), ci = *(const f32x4*)(P.in[I_CIM] + (size_t)(g * S5H + fr) * S5P + 16 * ks + 4 * fq);
            v4u w; w.x = pk_bf16(cr.x, -ci.x); w.y = pk_bf16(cr.y, -ci.y); w.z = pk_bf16(cr.z, -ci.z); w.w = pk_bf16(cr.w, -ci.w); ac[ks] = __builtin_bit_cast(bf16x8, w); }
        const f32x4 dsk = *(const f32x4*)(P.in[I_DSK] + g * S5H + 4 * fq);
        v4u pre[2]; s5_load_ub(U, b * SEQ + q * QLEN, g, lane, pre);
#pragma unroll 1
        for (int c = 0; c < CPQ; ++c) {
            const int row0 = b * SEQ + q * QLEN + c * CHUNK;
            s5_put_ub(wl + S5_UB, lane, pre);
            s5_load_ub(U, b * SEQ + q * QLEN + (c + 1 < CPQ ? c + 1 : c) * CHUNK, g, lane, pre);
#pragma unroll 1
            for (int blk = 0; blk < 4; ++blk) {
                s5_bu16(wl, 16 * blk, fr, fq, bop);
                s5_scan16<true>(wl, lane, are, aim, sre, sim);
                f32x4 acc = {0.f, 0.f, 0.f, 0.f};
#pragma unroll
                for (int ks = 0; ks < 4; ++ks) { const bf16x8 sb = *(const LAS bf16x8*)(wl + S5_SB + fr * 272 + 64 * ks + 16 * fq);
                    acc = __builtin_amdgcn_mfma_f32_16x16x32_bf16(ac[ks], sb, acc, 0, 0, 0); }
                asm volatile("s_nop 15" : "+v"(acc) :: "memory");
                const int t = 16 * blk + fr;
                const v2u ur = *(const LAS v2u*)(wl + S5_UB + t * 32 + 8 * fq);
                const float u0 = bf_lo(ur.x), u1 = bf_hi(ur.x), u2 = bf_lo(ur.y), u3 = bf_hi(ur.y);
                v2u w; w.x = pk_bf16(gelu_tanh(acc[0] + dsk[0] * u0), gelu_tanh(acc[1] + dsk[1] * u1)); w.y = pk_bf16(gelu_tanh(acc[2] + dsk[2] * u2), gelu_tanh(acc[3] + dsk[3] * u3));
                *(v2u*)(Y + (size_t)(row0 + t) * D + g * S5H + 4 * fq) = w;
                LDS_WAIT();
            }
        }
    }
}

__device__ __forceinline__ void sb_prep(const Params& P, LAS unsigned char* lds, int gw, int NGW, int wave, int lane) {
    bf16* QKV = (bf16*)(P.ws + WS_BIG); bf16* Vt = (bf16*)(P.ws + WS_T1);
    for (int task = gw; task < 2 * M; task += NGW) {
        const int m = task >> 1, which = task & 1;
        bf16* ptr = QKV + (size_t)m * NQKV + which * D + (lane >> 2) * HD + (lane & 3) * 32;
        const float* gain = P.in[which ? I_GK : I_GQ] + (lane & 3) * 32;
        v4u raw[4]; float v[32]; float ss = 0.f;
#pragma unroll
        for (int q = 0; q < 4; ++q) raw[q] = ((const v4u*)ptr)[q];
#pragma unroll
        for (int q = 0; q < 4; ++q)
#pragma unroll
            for (int e = 0; e < 4; ++e) { const unsigned w = raw[q][e]; v[8 * q + 2 * e] = bf_lo(w); v[8 * q + 2 * e + 1] = bf_hi(w); }
#pragma unroll
        for (int i = 0; i < 32; ++i) ss += v[i] * v[i];
        ss += __shfl_xor(ss, 1); ss += __shfl_xor(ss, 2);
        float rstd = 1.0f / sqrtf(ss * (1.f / HD) + EPS); if (!which) rstd *= 0.08838834764831845f;
#pragma unroll
        for (int q = 0; q < 4; ++q) { const f32x4 g0 = *(const f32x4*)(gain + 8 * q), g1 = *(const f32x4*)(gain + 8 * q + 4);
            v4u w; w.x = pk_bf16(v[8 * q] * rstd * g0.x, v[8 * q + 1] * rstd * g0.y); w.y = pk_bf16(v[8 * q + 2] * rstd * g0.z, v[8 * q + 3] * rstd * g0.w);
            w.z = pk_bf16(v[8 * q + 4] * rstd * g1.x, v[8 * q + 5] * rstd * g1.y); w.w = pk_bf16(v[8 * q + 6] * rstd * g1.z, v[8 * q + 7] * rstd * g1.w);
            ((v4u*)ptr)[q] = w; }
    }
    LAS unsigned char* tile = lds + wave * 16384;
    for (int task = gw; task < BATCH * NH * (SEQ / 32); task += NGW) {
        const int tb = task % (SEQ / 32), hh = (task / (SEQ / 32)) % NH, b = task / ((SEQ / 32) * NH);
#pragma unroll
        for (int i = 0; i < 8; ++i) { const int id = i * 64 + lane, tok = id >> 4, c = id & 15;
            const v4u x = *(const v4u*)(QKV + (size_t)(b * SEQ + tb * 32 + tok) * NQKV + 2 * D + hh * HD + c * 8);
            *(LAS v4u*)(tile + tok * 272 + c * 16) = x; }
        LDS_WAIT();
#pragma unroll
        for (int i = 0; i < 8; ++i) { const int id = i * 64 + lane, d = id >> 2, c = id & 3;
            unsigned short e[8];
#pragma unroll
            for (int j = 0; j < 8; ++j) e[j] = *(const LAS unsigned short*)(tile + (c * 8 + j) * 272 + d * 2);
            v4u w; w.x = e[0] | ((unsigned)e[1] << 16); w.y = e[2] | ((unsigned)e[3] << 16); w.z = e[4] | ((unsigned)e[5] << 16); w.w = e[6] | ((unsigned)e[7] << 16);
            *(v4u*)(Vt + ((size_t)((b * NH + hh) * HD + d)) * SEQ + tb * 32 + c * 8) = w; }
        LDS_WAIT();
    }
}
#define MFMA32(a, b, c) __builtin_amdgcn_mfma_f32_32x32x16_bf16((a), (b), (c), 0, 0, 0)
constexpr int AT_KSTR = 272, AT_VSTR = 72, AT_KBYTES = 32 * AT_KSTR, AT_WAVE_BYTES = AT_KBYTES + 128 * AT_VSTR;
__device__ __forceinline__ void sb_attn(const Params& P, LAS unsigned char* lds, int gw, int NGW, int wave, int lane) {
    const bf16* QKV = (const bf16*)(P.ws + WS_BIG); const bf16* Vt = (const bf16*)(P.ws + WS_T1); bf16* O = (bf16*)(P.ws + WS_T2);
    const int r = lane & 31, h = lane >> 5;
    LAS unsigned char* kbuf = lds + wave * AT_WAVE_BYTES; LAS unsigned char* vbuf = kbuf + AT_KBYTES;
    const int krow_l = lane >> 4, kc = lane & 15, vrow_l = lane >> 2, vc = lane & 3;
    for (int task = gw; task < BATCH * NH * (SEQ / 32); task += NGW) {
        const int qb = task % (SEQ / 32), hh = (task / (SEQ / 32)) % NH, b = task / ((SEQ / 32) * NH);
        const int q0 = 32 * qb, tq = q0 + r;
        const bf16* qrow = QKV + (size_t)(b * SEQ + q0 + r) * NQKV + hh * HD + 8 * h;
        bf16x8 qf[8];
#pragma unroll
        for (int s = 0; s < 8; ++s) qf[s] = *(const bf16x8*)(qrow + 16 * s);
        f32x16 o[4];
#pragma unroll
        for (int dt = 0; dt < 4; ++dt)
#pragma unroll
            for (int i = 0; i < 16; ++i) o[dt][i] = 0.f;
        float R = 0.f;
        const char* kbase = (const char*)(QKV + (size_t)(b * SEQ) * NQKV + D + hh * HD);
        const char* vbase = (const char*)(Vt + ((size_t)((b * NH + hh) * HD)) * SEQ);
        unsigned koff = (unsigned)(krow_l * NQKV + 8 * kc) * 2u, voff = (unsigned)(vrow_l * SEQ + 8 * vc) * 2u;
        asm volatile("" : "+v"(koff), "+v"(voff));
        v4u kraw[8], vraw[8];
#pragma unroll
        for (int i = 0; i < 8; ++i) { kraw[i] = *(const v4u*)(kbase + (size_t)(32 * qb + 4 * i) * (NQKV * 2) + koff); vraw[i] = *(const v4u*)(vbase + (size_t)(16 * i * SEQ + 32 * qb) * 2 + voff); }
        for (int kt = qb; kt >= 0; --kt) {
            const int k0 = 32 * kt;
#pragma unroll
            for (int i = 0; i < 8; ++i) { *(LAS v4u*)(kbuf + (4 * i + krow_l) * AT_KSTR + 16 * kc) = kraw[i];
                LAS v2u* vd = (LAS v2u*)(vbuf + (16 * i + vrow_l) * AT_VSTR + 16 * vc); vd[0] = (v2u){vraw[i].x, vraw[i].y}; vd[1] = (v2u){vraw[i].z, vraw[i].w}; }
            LDS_WAIT();
            { const int kn = kt > 0 ? kt - 1 : 0;
#pragma unroll
              for (int i = 0; i < 8; ++i) { kraw[i] = *(const v4u*)(kbase + (size_t)(32 * kn + 4 * i) * (NQKV * 2) + koff); vraw[i] = *(const v4u*)(vbase + (size_t)(16 * i * SEQ + 32 * kn) * 2 + voff); } }
            f32x16 x;
#pragma unroll
            for (int i = 0; i < 16; ++i) x[i] = 0.f;
#pragma unroll
            for (int s = 0; s < 8; ++s) { const bf16x8 kf = *(const LAS bf16x8*)(kbuf + r * AT_KSTR + 32 * s + 16 * h); x = MFMA32(kf, qf[s], x); }
            asm volatile("s_nop 7" ::: "memory");
            float lk[16], lb[16];
#pragma unroll
            for (int i = 0; i < 16; ++i) { const float z = x[i];
                const float sp = fmaxf(z, 0.f) + __builtin_amdgcn_logf(1.0f + __builtin_amdgcn_exp2f(-fabsf(z)));
                const int key = k0 + (i & 3) + 8 * (i >> 2) + 4 * h;
                lk[i] = (key < tq) ? -sp : 0.f; lb[i] = z - sp; }
            float gs[4], gp[4], e0[4], e1[4], e2[4];
#pragma unroll
            for (int g = 0; g < 4; ++g) { e2[g] = lk[4 * g + 3]; e1[g] = e2[g] + lk[4 * g + 2]; e0[g] = e1[g] + lk[4 * g + 1]; gs[g] = e0[g] + lk[4 * g]; gp[g] = __shfl_xor(gs[g], 32); }
            const float T0 = gs[0] + gp[0], T1 = gs[1] + gp[1], T2 = gs[2] + gp[2], T3 = gs[3] + gp[3];
            float base[4]; base[3] = R; base[2] = R + T3; base[1] = base[2] + T2; base[0] = base[1] + T1;
            const float total = (base[0] - R) + T0;
            float w[16];
#pragma unroll
            for (int g = 0; g < 4; ++g) { const float bg = base[g] + (h == 0 ? gp[g] : 0.f);
                const float s0 = bg + e0[g], s1 = bg + e1[g], s2 = bg + e2[g], s3 = bg;
                const int key = k0 + 8 * g + 4 * h;
                w[4 * g + 0] = (key + 0 < tq) ? __builtin_amdgcn_exp2f(lb[4 * g + 0] + s0) : 0.f;
                w[4 * g + 1] = (key + 1 < tq) ? __builtin_amdgcn_exp2f(lb[4 * g + 1] + s1) : 0.f;
                w[4 * g + 2] = (key + 2 < tq) ? __builtin_amdgcn_exp2f(lb[4 * g + 2] + s2) : 0.f;
                w[4 * g + 3] = (key + 3 < tq) ? __builtin_amdgcn_exp2f(lb[4 * g + 3] + s3) : 0.f; }
            R += total;
#pragma unroll
            for (int s = 0; s < 2; ++s) { v4u pw; pw.x = pk_bf16(w[8 * s], w[8 * s + 1]); pw.y = pk_bf16(w[8 * s + 2], w[8 * s + 3]); pw.z = pk_bf16(w[8 * s + 4], w[8 * s + 5]); pw.w = pk_bf16(w[8 * s + 6], w[8 * s + 7]);
                const bf16x8 xs = __builtin_bit_cast(bf16x8, pw);
#pragma unroll
                for (int dt = 0; dt < 4; ++dt) { const LAS unsigned char* vp = vbuf + (32 * dt + r) * AT_VSTR + 32 * s + 8 * h; const v2u lo = *(const LAS v2u*)vp, hi = *(const LAS v2u*)(vp + 16);
                    v4u pv; pv.x = lo.x; pv.y = lo.y; pv.z = hi.x; pv.w = hi.y;
                    o[dt] = MFMA32(__builtin_bit_cast(bf16x8, pv), xs, o[dt]); } }
            LDS_WAIT();
            if (__ballot(R > -152.0f) == 0ull) break;
        }
        asm volatile("s_nop 15" ::: "memory");
        bf16* orow = O + (size_t)(b * SEQ + q0 + r) * D + hh * HD + 4 * h;
#pragma unroll
        for (int dt = 0; dt < 4; ++dt)
#pragma unroll
            for (int g = 0; g < 4; ++g) { v2u w2; w2.x = pk_bf16(o[dt][4 * g], o[dt][4 * g + 1]); w2.y = pk_bf16(o[dt][4 * g + 2], o[dt][4 * g + 3]); *(v2u*)(orow + 32 * dt + 8 * g) = w2; }
    }
}

#define XB_TMO      128
#define XB_XCNT(j)  (256  + 64 * (j))
#define XB_XSUB(j)  (1280 + 64 * (j))
#define XB_XGEN(j)  (2304 + 64 * (j))
#define XB_TOP      3328
#define XB_TOPGEN   3392
#define XCD_BAR_WORDS 3456
#define XL_SUB(j)   (3456 + 64 * (j))
#define XL_GEN(j)   (4480 + 64 * (j))
#define XL_MAP(x)   (5504 + 64 * (x))
#define XL_BAR_WORDS 6016
#define XB_SPIN_CAP (1u << 18)

__device__ __forceinline__ unsigned xb_ld(unsigned* p)              { return __hip_atomic_load(p, __ATOMIC_RELAXED, __HIP_MEMORY_SCOPE_AGENT); }
__device__ __forceinline__ unsigned xb_add(unsigned* p, unsigned v) { return __hip_atomic_fetch_add(p, v, __ATOMIC_RELAXED, __HIP_MEMORY_SCOPE_AGENT); }
__device__ __forceinline__ unsigned xb_xcc_id() { return (unsigned)__builtin_amdgcn_s_getreg((3 << 11) | 20) & 0xFu; }
#define XB_SPIN(cond, bar) do { unsigned _sp = 0; while (cond) { __builtin_amdgcn_s_sleep(1); \
    if ((++_sp & 255u) == 0u) { if (xb_ld(&(bar)[XB_TMO])) break; if (_sp > XB_SPIN_CAP) { atomicAdd(&(bar)[XB_TMO], 1u); break; } } } } while (0)

struct XcdBarrier {
    unsigned* bar; unsigned x;
    volatile LAS unsigned* st;
};

__device__ __forceinline__ XcdBarrier xcd_barrier_post(unsigned* bar, volatile LAS unsigned* st) {
    XcdBarrier b; b.bar = bar; b.x = xb_xcc_id(); b.st = st;
    if (threadIdx.x == 0) (void)xb_add(&bar[XB_XCNT(b.x)], 1u);
    return b;
}
__device__ __forceinline__ void xcd_barrier_complete(unsigned* bar, unsigned x, unsigned& nloc, unsigned& nx) {
    const unsigned G = gridDim.x * gridDim.y * gridDim.z;
    unsigned sum, cnt, mine, sp = 0u;
    for (;;) {
        sum = 0u; cnt = 0u; mine = 0u;
#pragma unroll
        for (unsigned j = 0; j < 16; ++j) { const unsigned c = xb_ld(&bar[XB_XCNT(j)]); sum += c; cnt += (c > 0u) ? 1u : 0u; mine = (j == x) ? c : mine; }
        if (sum == G) break;
        __builtin_amdgcn_s_sleep(1);
        if ((++sp & 255u) == 0u) { if (xb_ld(&bar[XB_TMO])) break; if (sp > XB_SPIN_CAP) { atomicAdd(&bar[XB_TMO], 1u); break; } }
    }
    nloc = mine > 0u ? mine : 1u; nx = cnt > 0u ? cnt : 1u;
}

__device__ __forceinline__ void xcd_barrier(const XcdBarrier& b) {
    asm volatile("s_waitcnt vmcnt(0)" ::: "memory");
    __syncthreads();
    if (threadIdx.x == 0) {
        unsigned* bar = b.bar;
        __builtin_amdgcn_s_waitcnt(0);
        unsigned nloc = b.st[0], nx = b.st[1];
        if (nloc == 0u) { xcd_barrier_complete(bar, b.x, nloc, nx); b.st[0] = nloc; b.st[1] = nx; }
        const unsigned old = xb_add(&bar[XB_XSUB(b.x)], 1u);
        const unsigned gen = old / nloc;
        if (old + 1u == (gen + 1u) * nloc) {
            __builtin_amdgcn_fence(__ATOMIC_RELEASE, "agent");
            asm volatile("s_waitcnt vmcnt(0)" ::: "memory");
            const unsigned og = xb_add(&bar[XB_TOP], 1u);
            const unsigned tg = og / nx;
            if (og + 1u == (tg + 1u) * nx) xb_add(&bar[XB_TOPGEN], 1u);
            else XB_SPIN(xb_ld(&bar[XB_TOPGEN]) == tg, bar);
            __builtin_amdgcn_fence(__ATOMIC_ACQUIRE, "agent");
            xb_add(&bar[XB_XGEN(b.x)], 1u);
            asm volatile("s_waitcnt vmcnt(0)" ::: "memory");
        } else {
            XB_SPIN(xb_ld(&bar[XB_XGEN(b.x)]) == gen, bar);
            __builtin_amdgcn_fence(__ATOMIC_ACQUIRE, "agent");
            asm volatile("s_waitcnt vmcnt(0)" ::: "memory");
        }
    }
    __syncthreads();
}

__device__ __forceinline__ void xcd_local_barrier(const XcdBarrier& b) {
    asm volatile("s_waitcnt vmcnt(0)" ::: "memory");
    __syncthreads();
    if (threadIdx.x == 0) {
        unsigned* bar = b.bar;
        __builtin_amdgcn_s_waitcnt(0);
        unsigned nloc = b.st[0], nx = b.st[1];
        if (nloc == 0u) { xcd_barrier_complete(bar, b.x, nloc, nx); b.st[0] = nloc; b.st[1] = nx; }
        const unsigned old = xb_add(&bar[XL_SUB(b.x)], 1u);
        const unsigned gen = old / nloc;
        if (old + 1u == (gen + 1u) * nloc) xb_add(&bar[XL_GEN(b.x)], 1u);
        else XB_SPIN(xb_ld(&bar[XL_GEN(b.x)]) == gen, bar);
        __builtin_amdgcn_fence(__ATOMIC_ACQUIRE, "agent");
        asm volatile("s_waitcnt vmcnt(0)" ::: "memory");
    }
    __syncthreads();
}

constexpr int NPH = 17;
enum { T_P0 = 0, T_UP, T_DOWN, T_NORM, T_WIN, T_S5A, T_S5B, T_GLU, T_WOUT, T_QKV, T_PREP, T_ATTN, T_WO };
__global__ void __launch_bounds__(NTHREADS, 2) fwd_megakernel(Params P) {
    extern __shared__ __attribute__((aligned(16))) unsigned char lds_raw[];
    LAS unsigned char* lds = (LAS unsigned char*)lds_raw;
    cg::grid_group grid = cg::this_grid();
    volatile LAS unsigned* bst = (volatile LAS unsigned*)(lds + LDS_MISC);
    if (threadIdx.x < 4) bst[threadIdx.x] = 0u;
    __syncthreads();
    XcdBarrier xbar; xbar.bar = (unsigned*)(P.ws + WS_BAR); xbar.x = 0; xbar.st = bst;
    if (!MK_MULTI) { xbar = xcd_barrier_post((unsigned*)(P.ws + WS_BAR), bst);
        if (threadIdx.x == 0) __hip_atomic_fetch_or((unsigned*)(P.ws + WS_BAR) + XL_MAP(blockIdx.x & 7), 1u << xbar.x, __ATOMIC_RELAXED, __HIP_MEMORY_SCOPE_AGENT); }
    for (int ph = P.ph_lo; ph < P.ph_hi; ++ph) {
        int tid = threadIdx.x; asm volatile("" : "+v"(tid));
        const int lane = tid & 63, wave = __builtin_amdgcn_readfirstlane(tid >> 6);
        const int G = gridDim.x, gw = blockIdx.x * NWAVES + wave, NGW = G * NWAVES;
        unsigned char* ws = P.ws;
        bf16* Hb = (bf16*)(ws + WS_H);
        int type, idx = 0;
        int ssi = 0, sso = 6;
        switch (ph) {
            case 0: type = T_P0; break;
            case 1: type = T_UP; idx = 0; ssi = 0; break;   case 2: type = T_DOWN; idx = 0; sso = 1; break;
            case 3: type = T_WIN; ssi = 1; break; case 4: type = T_S5A; break; case 5: type = T_S5B; break; case 6: type = T_GLU; break; case 7: type = T_WOUT; sso = 2; break;
            case 8: type = T_UP; idx = 1; ssi = 2; break;   case 9: type = T_DOWN; idx = 1; sso = 3; break;
            case 10: type = T_UP; idx = 2; ssi = 3; break;  case 11: type = T_DOWN; idx = 2; sso = 4; break;
            case 12: type = T_QKV; ssi = 4; break; case 13: type = T_ATTN; break; case 14: type = T_WO; sso = 5; break;
            case 15: type = T_UP; idx = 3; ssi = 5; break;  default: type = T_DOWN; idx = 3; break;
        }
        const float* SSi = (const float*)(ws + WS_SS) + (size_t)ssi * M; float* SSo = (float*)(ws + WS_SS) + (size_t)sso * M;
        if (type == T_P0) p0_phase(P, lds, gw, NGW, wave, lane);
        else if (type == T_UP) {
            pg8::Gemm g{Hb, (const bf16*)(ws + WS_WGU + (size_t)idx * FFN_SET_BYTES), M, 2 * FF, D}; pg8::StaticOrder S; S.init(M, 2 * FF, G, (int)blockIdx.x);
            pg8::EpiSwiGLU E{(bf16*)(ws + WS_BIG), FF, SSi, lds};
            pg8::gemm_phase<pg8::EpiSwiGLU, pg8::StaticOrder, true, true>(lds, g, S, E, tid);
        } else if (type == T_DOWN || type == T_WOUT || type == T_WO) {
            const bf16* A = type == T_DOWN ? (const bf16*)(ws + WS_BIG) : (const bf16*)(ws + WS_T2);
            const bf16* Bt = type == T_DOWN ? (const bf16*)(ws + WS_WGU + (size_t)idx * FFN_SET_BYTES + WGU_BYTES) : type == T_WOUT ? (const bf16*)(ws + WS_WOUT) : (const bf16*)(ws + WS_WO);
            const int K = type == T_DOWN ? FF : D;
            pg8::Gemm g{A, Bt, M, D, K}; pg8::StaticOrder S; S.init(M, D, G, (int)blockIdx.x, 4);
            pg8::EpiRes E{ph == NPH - 1 ? P.out : nullptr, D, type == T_DOWN ? 1 : 0, Hb, SSo};
            pg8::gemm_phase<pg8::EpiRes, pg8::StaticOrder, true, true>(lds, g, S, E, tid);
        } else if (type == T_WIN) {
            pg8::Gemm g{Hb, (const bf16*)(ws + WS_WIN), M, D, D}; pg8::StaticOrder S; S.init(M, D, G, (int)blockIdx.x);
            pg8::EpiBf16 E{(bf16*)(ws + WS_BIG), D, SSi, lds};
            pg8::gemm_phase<pg8::EpiBf16, pg8::StaticOrder, true, true>(lds, g, S, E, tid);
        } else if (type == T_S5A) s5_pass_a2(P, lds, gw, NGW, wave, lane);
        else if (type == T_S5B) s5_pass_b2(P, lds, gw, NGW, wave, lane);
        else if (type == T_GLU) {
            pg8::Gemm g{(const bf16*)(ws + WS_T1), (const bf16*)(ws + WS_WGLU), M, D, D}; pg8::StaticOrder S; S.init(M, D, G, (int)blockIdx.x);
            pg8::EpiGlu E{(const bf16*)(ws + WS_T1), (bf16*)(ws + WS_T2), D, P.in[I_BGLU]};
            pg8::gemm_phase<pg8::EpiGlu, pg8::StaticOrder, true, true>(lds, g, S, E, tid);
        } else if (type == T_QKV) {
            pg8::Gemm g{Hb, (const bf16*)(ws + WS_WQKV), M, NQKV, D}; pg8::StaticOrder S; S.init(M, NQKV, G, (int)blockIdx.x);
            pg8::EpiQKV E{(bf16*)(ws + WS_BIG), NQKV, SSi, lds, P.in[I_GQ], P.in[I_GK], (bf16*)(ws + WS_T1)};
            pg8::gemm_phase<pg8::EpiQKV, pg8::StaticOrder, true, true>(lds, g, S, E, tid);
        } else if (type == T_PREP) sb_prep(P, lds, gw, NGW, wave, lane);
        else if (type == T_ATTN) sb_attn(P, lds, gw, NGW, wave, lane);
        if (ph + 1 < P.ph_hi) {
            if (ph == 0) { grid.sync();
                if (threadIdx.x == 0) { unsigned ok = (gridDim.x % 8u == 0u) ? 1u : 0u;
                    for (int xx = 0; xx < 8; ++xx) { const unsigned mk = xb_ld((unsigned*)(P.ws + WS_BAR) + XL_MAP(xx)); ok &= (mk != 0u && (mk & (mk - 1u)) == 0u) ? 1u : 0u; }
                    bst[2] = ok; }
                __syncthreads(); }
            else { const bool gemm_seam = (ph == 1 || (ph >= 6 && ph <= 10) || ph == 14 || ph == 15);
                if (gemm_seam && bst[2] != 0u) xcd_local_barrier(xbar); else xcd_barrier(xbar); } }
    }
}

extern "C" void kernel_launch(void* const* d_in, const int* in_sizes, int n_in, void* d_out, int out_size, void* d_ws, size_t ws_size, hipStream_t stream) {
    static int grid = 0;
    if (grid == 0) {
        if (n_in != 26 || in_sizes[0] != M * D || out_size != M * D || ws_size < WS_END) { fprintf(stderr, "kernel_launch: unexpected shapes (n_in %d, in0 %d, out %d, ws %zu)\n", n_in, n_in > 0 ? in_sizes[0] : -1, out_size, ws_size); grid = -1; return; }
        int dev = 0, cus = 0, per_cu = 0;
        if (hipGetDevice(&dev) != hipSuccess || hipDeviceGetAttribute(&cus, hipDeviceAttributeMultiprocessorCount, dev) != hipSuccess) { fprintf(stderr, "kernel_launch: device query failed\n"); grid = -1; return; }
        if (hipFuncSetAttribute((const void*)fwd_megakernel, hipFuncAttributeMaxDynamicSharedMemorySize, LDS_BYTES) != hipSuccess) { fprintf(stderr, "kernel_launch: hipFuncSetAttribute failed\n"); grid = -1; return; }
        if (hipOccupancyMaxActiveBlocksPerMultiprocessor(&per_cu, (const void*)fwd_megakernel, NTHREADS, LDS_BYTES) != hipSuccess || per_cu < 1) { fprintf(stderr, "kernel_launch: occupancy query says %d blocks per CU\n", per_cu); per_cu = 1; }
        (void)hipGetLastError();
        grid = cus * per_cu;
        fprintf(stderr, "kernel_launch: grid %d (%d CUs x %d)\n", grid, cus, per_cu);
    }
    if (grid < 0) return;
    Params p{};
    for (int i = 0; i < 26; ++i) p.in[i] = (const float*)d_in[i];
    p.out = (float*)d_out; p.ws = (unsigned char*)d_ws;
#if MK_MULTI
    for (int ph = 0; ph < NPH; ++ph) { p.ph_lo = ph; p.ph_hi = ph + 1;
        hipLaunchKernelGGL(fwd_megakernel, dim3(grid), dim3(NTHREADS), LDS_BYTES, stream, p);
        const hipError_t le = hipPeekAtLastError(); if (le != hipSuccess) { fprintf(stderr, "kernel_launch: launch %d failed: %s\n", ph, hipGetErrorName(le)); break; } }
#else
    p.ph_lo = 0; p.ph_hi = NPH;
    if (hipMemsetAsync((char*)d_ws + WS_BAR, 0, XL_BAR_WORDS * 4, stream) != hipSuccess) { fprintf(stderr, "kernel_launch: memset failed\n"); return; }
    void* args[] = {&p};
    const hipError_t le = hipLaunchCooperativeKernel((const void*)fwd_megakernel, dim3(grid), dim3(NTHREADS), args, LDS_BYTES, stream);
    if (le != hipSuccess) fprintf(stderr, "kernel_launch: cooperative launch failed: %s (grid %d)\n", hipGetErrorString(le), grid);
#endif
}
```
